# Optimizing an MI355X kernel written in HIP

```python
import math
import jax, jax.numpy as jnp
from jax import lax
import numpy as np


D_MODEL = 1024
BATCH = 32
SEQ = 2048
DEPTH = 4

D_MIX = D_MODEL
D_S5 = D_MIX // 2
S5_GROUP = 16
S5_GROUPS = D_S5 // S5_GROUP
S5_STATE = 64
DT_MIN = 0.001
DT_MAX = 0.1
D_GLA = D_MIX - D_S5
GLA_HEADS = 4
GLA_DV = D_GLA // GLA_HEADS
GLA_DK = GLA_DV // 2
GLA_KDIM = GLA_HEADS * GLA_DK
GLA_GATE_RANK = 16
GLA_GATE_NORM = 16.0
GLA_CHUNK = 64
D_IN = D_S5 + 2 * GLA_KDIM + 2 * D_GLA + GLA_GATE_RANK
D_FF = 256 * (-(-(8 * D_MODEL) // (3 * 256)))
EPS = 1e-6

kernel_name = "hymba_s5_gla_hybrid_trunk"


def _rmsnorm(x, gain):
    xf = x.astype(jnp.float32)
    y = xf * lax.rsqrt(jnp.mean(xf * xf, axis=-1, keepdims=True) + EPS)
    return (y * gain.astype(jnp.float32)).astype(x.dtype)


def _complex_linear_combine(e1, e2):
    ar1, ai1, br1, bi1 = e1
    ar2, ai2, br2, bi2 = e2
    return (ar1 * ar2 - ai1 * ai2,
            ar1 * ai2 + ai1 * ar2,
            ar2 * br1 - ai2 * bi1 + br2,
            ar2 * bi1 + ai2 * br1 + bi2)


def _s5_mixer(u, lam_re, lam_im, b_re, b_im, c_re, c_im, d_skip, log_step):
    f32 = jnp.float32
    bsz, seq, _ = u.shape
    uf = u.astype(f32).reshape(bsz, seq, S5_GROUPS, S5_GROUP)
    step = jnp.exp(log_step.astype(f32))[:, None]
    lr = lam_re.astype(f32)
    li = lam_im.astype(f32)
    mag = jnp.exp(lr * step)
    ar = mag * jnp.cos(li * step)
    ai = mag * jnp.sin(li * step)
    den = lr * lr + li * li
    fr = ((ar - 1.0) * lr + ai * li) / den
    fi = (ai * lr - (ar - 1.0) * li) / den
    br = b_re.astype(f32)
    bi = b_im.astype(f32)
    bbar_re = fr[..., None] * br - fi[..., None] * bi
    bbar_im = fr[..., None] * bi + fi[..., None] * br
    xr = jnp.einsum('gph,blgh->lbgp', bbar_re, uf)
    xi = jnp.einsum('gph,blgh->lbgp', bbar_im, uf)
    a_re = jnp.broadcast_to(ar, (seq, 1, S5_GROUPS, S5_STATE))
    a_im = jnp.broadcast_to(ai, (seq, 1, S5_GROUPS, S5_STATE))
    _, _, sr, si = lax.associative_scan(_complex_linear_combine, (a_re, a_im, xr, xi), axis=0)
    y = (jnp.einsum('ghp,lbgp->blgh', c_re.astype(f32), sr)
         - jnp.einsum('ghp,lbgp->blgh', c_im.astype(f32), si))
    y = y + d_skip.astype(f32).reshape(S5_GROUPS, S5_GROUP) * uf
    return y.reshape(bsz, seq, D_S5)


def _gla_mixer(q, k, v, g, gate_lr, w_gate, b_gate, out_norm):
    f32 = jnp.float32
    bsz, seq, _ = q.shape
    n_chunks = seq // GLA_CHUNK
    log_a = jax.nn.log_sigmoid(gate_lr.astype(f32) @ w_gate.astype(f32) + b_gate.astype(f32)) / GLA_GATE_NORM

    def chunked(t, dh):
        return t.astype(f32).reshape(bsz, n_chunks, GLA_CHUNK, GLA_HEADS, dh).transpose(0, 3, 1, 2, 4)

    qc = chunked(q, GLA_DK) * (GLA_DK ** -0.5)
    kc = chunked(k, GLA_DK)
    vc = chunked(v, GLA_DV)
    cum = jnp.cumsum(chunked(log_a, GLA_DK), axis=3)
    last = cum[:, :, :, -1:, :]
    q_dec = qc * jnp.exp(cum)
    k_inv = kc * jnp.exp(-cum)
    k_end = kc * jnp.exp(last - cum)
    causal = jnp.tril(jnp.ones((GLA_CHUNK, GLA_CHUNK), dtype=bool))
    scores = jnp.where(causal, jnp.einsum('bhntk,bhnsk->bhnts', q_dec, k_inv), 0.0)
    o_intra = jnp.einsum('bhnts,bhnsv->bhntv', scores, vc)
    upd = jnp.einsum('bhnsk,bhnsv->bhnkv', k_end, vc)
    decay = jnp.exp(last[:, :, :, 0, :])

    def step(state, inp):
        dec, u = inp
        return dec[..., None] * state + u, state

    s0 = jnp.zeros((bsz, GLA_HEADS, GLA_DK, GLA_DV), f32)
    _, s_prev = lax.scan(step, s0, (jnp.moveaxis(decay, 2, 0), jnp.moveaxis(upd, 2, 0)))
    s_prev = jnp.moveaxis(s_prev, 0, 2)
    o = o_intra + jnp.einsum('bhntk,bhnkv->bhntv', q_dec, s_prev)
    o = o.transpose(0, 2, 3, 1, 4).reshape(bsz, seq, GLA_HEADS, GLA_DV)
    o = o * lax.rsqrt(jnp.mean(o * o, axis=-1, keepdims=True) + EPS)
    o = o.reshape(bsz, seq, D_GLA) * out_norm.astype(f32)
    return jax.nn.silu(g.astype(f32)) * o


def _normal(k, shape, scale):
    return scale * jax.random.normal(k, shape, jnp.float32)


def setup_inputs(seed: int = 0) -> dict:
    key = jax.random.key(seed)
    ks = jax.random.split(key, 22)
    n_idx = jnp.arange(S5_STATE, dtype=jnp.float32)
    lam_im = jnp.broadcast_to(jnp.pi * n_idx, (DEPTH, S5_GROUPS, S5_STATE))
    return {
        'x': _normal(ks[0], (BATCH, SEQ, D_MODEL), 1.0),
        'norm_mix': 1.0 + _normal(ks[1], (DEPTH, D_MODEL), 0.02),
        'w_in': _normal(ks[2], (DEPTH, D_MODEL, D_IN), D_MODEL ** -0.5),
        's5_lam_re': -0.5 + _normal(ks[3], (DEPTH, S5_GROUPS, S5_STATE), 0.01),
        's5_lam_im': lam_im + _normal(ks[4], (DEPTH, S5_GROUPS, S5_STATE), 0.01),
        's5_b_re': _normal(ks[5], (DEPTH, S5_GROUPS, S5_STATE, S5_GROUP), (2 * S5_GROUP) ** -0.5),
        's5_b_im': _normal(ks[6], (DEPTH, S5_GROUPS, S5_STATE, S5_GROUP), (2 * S5_GROUP) ** -0.5),
        's5_c_re': _normal(ks[7], (DEPTH, S5_GROUPS, S5_GROUP, S5_STATE), S5_STATE ** -0.5),
        's5_c_im': _normal(ks[8], (DEPTH, S5_GROUPS, S5_GROUP, S5_STATE), S5_STATE ** -0.5),
        's5_d': _normal(ks[9], (DEPTH, D_S5), 1.0),
        's5_log_step': jax.random.uniform(ks[10], (DEPTH, S5_GROUPS), jnp.float32,
                                          minval=math.log(DT_MIN), maxval=math.log(DT_MAX)),
        's5_w_glu': _normal(ks[11], (DEPTH, D_S5, D_S5), D_S5 ** -0.5),
        's5_b_glu': _normal(ks[12], (DEPTH, D_S5), 0.02),
        's5_out_norm': 1.0 + _normal(ks[13], (DEPTH, D_S5), 0.02),
        'gla_w_gate': _normal(ks[14], (DEPTH, GLA_GATE_RANK, GLA_KDIM), GLA_GATE_RANK ** -0.5),
        'gla_b_gate': _normal(ks[15], (DEPTH, GLA_KDIM), 0.1),
        'gla_out_norm': 1.0 + _normal(ks[16], (DEPTH, D_GLA), 0.02),
        'w_out': _normal(ks[17], (DEPTH, D_MIX, D_MODEL), D_MIX ** -0.5),
        'norm_ffn': 1.0 + _normal(ks[18], (DEPTH, D_MODEL), 0.02),
        'w_ffn_in': _normal(ks[19], (DEPTH, D_MODEL, 2 * D_FF), D_MODEL ** -0.5),
        'w_ffn_out': _normal(ks[20], (DEPTH, D_FF, D_MODEL), D_FF ** -0.5),
        'norm_final': 1.0 + _normal(ks[21], (D_MODEL,), 0.02),
    }


def reference(x, norm_mix, w_in, s5_lam_re, s5_lam_im, s5_b_re, s5_b_im, s5_c_re, s5_c_im,
              s5_d, s5_log_step, s5_w_glu, s5_b_glu, s5_out_norm, gla_w_gate, gla_b_gate,
              gla_out_norm, w_out, norm_ffn, w_ffn_in, w_ffn_out, norm_final):
    o_q = D_S5
    o_k = o_q + GLA_KDIM
    o_v = o_k + GLA_KDIM
    o_g = o_v + D_GLA
    o_r = o_g + D_GLA
    for i in range(DEPTH):
        h = _rmsnorm(x, norm_mix[i])
        z = h @ w_in[i]
        u_s5 = z[..., :o_q]
        q = z[..., o_q:o_k]
        k = z[..., o_k:o_v]
        v = z[..., o_v:o_g]
        g = z[..., o_g:o_r]
        gate_lr = z[..., o_r:]
        y = _s5_mixer(u_s5, s5_lam_re[i], s5_lam_im[i], s5_b_re[i], s5_b_im[i],
                      s5_c_re[i], s5_c_im[i], s5_d[i], s5_log_step[i])
        y = jax.nn.gelu(y)
        y = y * jax.nn.sigmoid(y @ s5_w_glu[i].astype(jnp.float32) + s5_b_glu[i].astype(jnp.float32))
        y_s5 = _rmsnorm(y, s5_out_norm[i]).astype(x.dtype)
        y_gla = _gla_mixer(q, k, v, g, gate_lr, gla_w_gate[i], gla_b_gate[i], gla_out_norm[i]).astype(x.dtype)
        x = x + jnp.concatenate([y_s5, y_gla], axis=-1) @ w_out[i]
        h = _rmsnorm(x, norm_ffn[i])
        gu = h @ w_ffn_in[i]
        x = x + (jax.nn.silu(gu[..., :D_FF]) * gu[..., D_FF:]) @ w_ffn_out[i]
    return _rmsnorm(x, norm_final)
```

```cpp
#include <hip/hip_runtime.h>
#include <cstdio>
#include <cstdint>


namespace pg8 {
#define PG8_LAS __attribute__((address_space(3)))
typedef unsigned short bf16_t;
typedef short bf16x8 __attribute__((ext_vector_type(8)));
typedef float f32x4 __attribute__((ext_vector_type(4)));
typedef unsigned u32x4 __attribute__((ext_vector_type(4)));
typedef unsigned u32x2 __attribute__((ext_vector_type(2)));
constexpr int BM = 256, BK = 64, HALF = 128, HTB = HALF * BK * 2, STAGE_BYTES = 8 * HTB, NXCD = 8, WGM = 8;

__host__ __device__ __forceinline__ int lds_byte(int r, int c) { const int st = (r >> 4) * 2 + (c >> 5), rr = r & 15, cc = c & 31, ob = rr * 64 + cc * 2; return st * 1024 + (ob ^ (((ob >> 9) & 1) << 5)); }
__host__ __device__ __forceinline__ void stage_rc(int b, int& R, int& C) { const int st = b / 1024, sb = b % 1024, swz = sb ^ (((sb >> 9) & 1) << 5); R = (st >> 1) * 16 + swz / 64; C = (st & 1) * 32 + (swz % 64) / 2; }
__host__ __device__ __forceinline__ int perm32(int rho) { const int n = rho >> 4, i = rho & 15; return 8 * (i >> 2) + 4 * n + (i & 3); }

struct Unit { int pm, pn; };
struct Gemm { const bf16_t* A; const bf16_t* Bt; int M, N, K, lda, ldb, gshift; size_t gstrideB; int ashift; size_t astrideA; size_t kstepA, tstepA; };

struct StaticOrder {
    int nM, nN, nwg, G, c;
    __host__ __device__ void init(int M, int N, int G_, int c_) { nM = M / BM; nN = N / BM; nwg = nM * nN; G = G_; c = c_; }
    __host__ __device__ bool next(int i, Unit& u) const {
        const long L = (long)i * G + c; if (L >= nwg) return false;
        int wgid = (int)L; { const int q = nwg / NXCD, r = nwg % NXCD, xcd = wgid % NXCD, off = wgid / NXCD; wgid = (xcd < r ? xcd * (q + 1) : r * (q + 1) + (xcd - r) * q) + off; }
        const int nig = WGM * nN, gid = wgid / nig, fm = gid * WGM, gsz = (nM - fm) < WGM ? (nM - fm) : WGM;
        u.pm = fm + ((wgid % nig) % gsz); u.pn = (wgid % nig) / gsz; return true;
    }
    __device__ __forceinline__ void a_ready(const Unit&) const {}
    __device__ __forceinline__ void done(const Unit&) const {}
};

__device__ __forceinline__ unsigned cvt_pk_bf16(float lo, float hi) { unsigned r; asm volatile("v_cvt_pk_bf16_f32 %0, %1, %2" : "=v"(r) : "v"(lo), "v"(hi)); return r; }

template <class Epi, class Sched, bool ALIGN_EPI = true, bool SP2 = true>
__device__ __forceinline__ void gemm_phase(PG8_LAS unsigned char* lds, const Gemm g, const Sched& S, const Epi& E) {
    int tid_ = threadIdx.x; asm volatile("" : "+v"(tid_));
    const int tid = tid_, wid = __builtin_amdgcn_readfirstlane(tid >> 6), lane = tid & 63, wr = wid >> 2, wc = wid & 3, fr = lane & 15, fq = lane >> 4;
    const int K = g.K, nt = K / BK;
    unsigned voffA[2], voffB[2];
#pragma unroll
    for (int i = 0; i < 2; ++i) { int R, C; stage_rc(tid * 16 + i * 8192, R, C); const int Rb = Epi::PERM ? ((R & ~31) + perm32(R & 31)) : R;
        voffA[i] = (unsigned)(R * g.lda + C) * 2u; voffB[i] = (unsigned)(Rb * g.ldb + C) * 2u; }
    const size_t kstep = (size_t)(BK * 2), kstepA = g.kstepA ? g.kstepA : kstep;
    const size_t hstepA = (size_t)HALF * g.lda * 2, hstepB = (size_t)HALF * g.ldb * 2;
    const size_t tstepA = g.tstepA ? g.tstepA : 2 * hstepA, tstepB = 2 * hstepB;
    const unsigned ldsw = (unsigned)wid * 1024u;
    const int aoff = lds_byte(wr * 64 + fr, fq * 8), boff = lds_byte(wc * 32 + fr, fq * 8);
#define PG8_SA(b, h) (((b) * 2 + (h)) * HTB)
#define PG8_SB(b, h) ((4 + (b) * 2 + (h)) * HTB)
#define PG8_STAGE(bufoff, gbase, voff) do { _Pragma("unroll") for (int _i = 0; _i < 2; ++_i) \
        __builtin_amdgcn_global_load_lds((const unsigned*)((const char*)(gbase) + (voff)[_i]), (PG8_LAS unsigned*)(lds + (bufoff) + ldsw + _i * 8192), 16, 0, 0); } while (0)
#define PG8_LDA(dst, b, h) do { _Pragma("unroll") for (int m = 0; m < 4; ++m) _Pragma("unroll") for (int k = 0; k < 2; ++k) dst[m][k] = *(const PG8_LAS bf16x8*)(lds + PG8_SA(b, h) + aoff + m * 2048 + k * 1024); } while (0)
#define PG8_LDB(dst, b, h) do { _Pragma("unroll") for (int n = 0; n < 2; ++n) _Pragma("unroll") for (int k = 0; k < 2; ++k) dst[n][k] = *(const PG8_LAS bf16x8*)(lds + PG8_SB(b, h) + boff + n * 2048 + k * 1024); } while (0)
#define PG8_MMA(ai, bj, At, Bt) do { __builtin_amdgcn_s_setprio(1); _Pragma("unroll") for (int m = 0; m < 4; ++m) _Pragma("unroll") for (int n = 0; n < 2; ++n) _Pragma("unroll") for (int k = 0; k < 2; ++k) \
        acc[ai][bj][m][n] = __builtin_amdgcn_mfma_f32_16x16x32_bf16(Bt[n][k], At[m][k], acc[ai][bj][m][n], 0, 0, 0); __builtin_amdgcn_s_setprio(0); } while (0)
#define PG8_WAIT_V(n) asm volatile("s_waitcnt vmcnt(" #n ")" ::: "memory")
#define PG8_WAIT_L(n) asm volatile("s_waitcnt lgkmcnt(" #n ")" ::: "memory")
#define PG8_BAR __builtin_amdgcn_s_barrier()
#define PG8_SCHED __builtin_amdgcn_sched_barrier(0)
    Unit cur, nxt; int ui = 0;
    if (!S.next(0, cur)) return;
    f32x4 acc[2][2][4][2];
#pragma unroll
    for (int a = 0; a < 2; ++a)
#pragma unroll
        for (int b = 0; b < 2; ++b)
#pragma unroll
            for (int m = 0; m < 4; ++m)
#pragma unroll
                for (int n = 0; n < 2; ++n) acc[a][b][m][n] = (f32x4){0.f, 0.f, 0.f, 0.f};
    bf16x8 At[4][2], B0[2][2], B1[2][2];
    const int amask = (1 << g.ashift) - 1;
    const char* cA = (const char*)g.A + (size_t)(cur.pm >> g.ashift) * g.astrideA + (size_t)(cur.pm & amask) * tstepA; const char* cB = (const char*)g.Bt + (size_t)(cur.pm >> g.gshift) * g.gstrideB + (size_t)cur.pn * tstepB;
    S.a_ready(cur);
    if constexpr (SP2) {
        PG8_STAGE(PG8_SB(0, 0), cB, voffB); PG8_STAGE(PG8_SB(0, 1), cB + hstepB, voffB); PG8_STAGE(PG8_SA(0, 0), cA, voffA); PG8_STAGE(PG8_SA(0, 1), cA + hstepA, voffA);
        if (wr == 1) PG8_BAR;
        PG8_WAIT_V(2); PG8_BAR;
        PG8_STAGE(PG8_SB(1, 0), cB + kstep, voffB); PG8_STAGE(PG8_SA(1, 0), cA + kstepA, voffA); PG8_STAGE(PG8_SB(1, 1), cB + hstepB + kstep, voffB);
        PG8_WAIT_V(6); PG8_BAR;
    } else {
        PG8_STAGE(PG8_SB(0, 0), cB, voffB); PG8_STAGE(PG8_SA(0, 0), cA, voffA); PG8_STAGE(PG8_SB(0, 1), cB + hstepB, voffB); PG8_STAGE(PG8_SA(0, 1), cA + hstepA, voffA);
        if (wr == 1) PG8_BAR;
        PG8_WAIT_V(4); PG8_BAR;
        PG8_STAGE(PG8_SB(1, 0), cB + kstep, voffB); PG8_STAGE(PG8_SA(1, 0), cA + kstepA, voffA); PG8_STAGE(PG8_SB(1, 1), cB + hstepB + kstep, voffB);
        PG8_WAIT_V(6); PG8_BAR;
    }
    for (;;) {
        const bool has_next = S.next(ui + 1, nxt);
        const char* nA = has_next ? (const char*)g.A + (size_t)(nxt.pm >> g.ashift) * g.astrideA + (size_t)(nxt.pm & amask) * tstepA : cA;
        const char* nB = has_next ? (const char*)g.Bt + (size_t)(nxt.pm >> g.gshift) * g.gstrideB + (size_t)nxt.pn * tstepB : cB;
#pragma nounroll
        for (int t = 0; t < nt; t += 2) {
            const bool last = (t == nt - 2);
            const char* a1 = cA + (size_t)(t + 1) * kstepA;
            const char* a2 = last ? nA : cA + (size_t)(t + 2) * kstepA; const char* b2 = last ? nB : cB + (size_t)(t + 2) * kstep;
            const char* a3 = a2 + kstepA; const char* b3 = b2 + kstep;
            if (last && has_next) S.a_ready(nxt);
            if constexpr (SP2) {
            PG8_LDB(B0, 0, 0); PG8_LDB(B1, 0, 1); PG8_SCHED; PG8_LDA(At, 0, 0); PG8_STAGE(PG8_SA(1, 1), a1 + hstepA, voffA);
            PG8_WAIT_V(8); PG8_WAIT_L(0); PG8_BAR; PG8_MMA(0, 0, At, B0); PG8_MMA(0, 1, At, B1); PG8_BAR; PG8_SCHED;
            PG8_LDA(At, 0, 1); PG8_STAGE(PG8_SB(0, 0), b2, voffB); PG8_STAGE(PG8_SB(0, 1), b2 + hstepB, voffB); PG8_STAGE(PG8_SA(0, 0), a2, voffA);
            PG8_WAIT_V(8); PG8_WAIT_L(0); PG8_BAR; PG8_MMA(1, 0, At, B0); PG8_MMA(1, 1, At, B1); PG8_BAR; PG8_SCHED;
            PG8_LDB(B0, 1, 0); PG8_LDB(B1, 1, 1); PG8_SCHED; PG8_LDA(At, 1, 0); PG8_STAGE(PG8_SA(0, 1), a2 + hstepA, voffA);
            PG8_WAIT_V(8); PG8_WAIT_L(0); PG8_BAR; PG8_MMA(0, 0, At, B0); PG8_MMA(0, 1, At, B1); PG8_BAR; PG8_SCHED;
            PG8_LDA(At, 1, 1); PG8_STAGE(PG8_SB(1, 0), b3, voffB); PG8_STAGE(PG8_SB(1, 1), b3 + hstepB, voffB); PG8_STAGE(PG8_SA(1, 0), a3, voffA);
            PG8_WAIT_V(8); PG8_WAIT_L(0); PG8_BAR; PG8_MMA(1, 0, At, B0); PG8_MMA(1, 1, At, B1); PG8_BAR; PG8_SCHED;
            if constexpr (Epi::KSCALE_T >= 0) { if (t == Epi::KSCALE_T) E.kscale(acc, cur, wr, fr); }
            } else {
            PG8_LDB(B0, 0, 0); PG8_SCHED; PG8_LDA(At, 0, 0); PG8_STAGE(PG8_SA(1, 1), a1 + hstepA, voffA);
            PG8_WAIT_L(8); PG8_BAR; PG8_WAIT_L(0); PG8_MMA(0, 0, At, B0); PG8_BAR; PG8_SCHED;
            PG8_LDB(B1, 0, 1); PG8_STAGE(PG8_SB(0, 0), b2, voffB);
            PG8_BAR; PG8_WAIT_L(0); PG8_MMA(0, 1, At, B1); PG8_BAR;
            PG8_LDA(At, 0, 1); PG8_STAGE(PG8_SA(0, 0), a2, voffA);
            PG8_BAR; PG8_WAIT_L(0); PG8_MMA(1, 0, At, B0); PG8_BAR; PG8_SCHED;
            PG8_STAGE(PG8_SB(0, 1), b2 + hstepB, voffB);
            PG8_WAIT_V(6); PG8_BAR; PG8_MMA(1, 1, At, B1); PG8_BAR;
            PG8_LDB(B0, 1, 0); PG8_SCHED; PG8_LDA(At, 1, 0); PG8_STAGE(PG8_SA(0, 1), a2 + hstepA, voffA);
            PG8_WAIT_L(8); PG8_BAR; PG8_WAIT_L(0); PG8_MMA(0, 0, At, B0); PG8_BAR; PG8_SCHED;
            PG8_LDB(B1, 1, 1); PG8_STAGE(PG8_SB(1, 0), b3, voffB);
            PG8_BAR; PG8_WAIT_L(0); PG8_MMA(0, 1, At, B1); PG8_BAR;
            PG8_LDA(At, 1, 1); PG8_STAGE(PG8_SA(1, 0), a3, voffA);
            PG8_BAR; PG8_WAIT_L(0); PG8_MMA(1, 0, At, B0); PG8_BAR; PG8_SCHED;
            PG8_STAGE(PG8_SB(1, 1), b3 + hstepB, voffB);
            PG8_WAIT_V(6); PG8_BAR; PG8_MMA(1, 1, At, B1); PG8_BAR;
            }
        }
        if constexpr (ALIGN_EPI) { if (wr == 0) PG8_BAR; }
        if constexpr (!Epi::AFTER_DRAIN) E(acc, cur, wr, wc, fr, fq);
        S.done(cur);
        if (!has_next) break;
#pragma unroll
        for (int a = 0; a < 2; ++a)
#pragma unroll
            for (int b = 0; b < 2; ++b)
#pragma unroll
                for (int m = 0; m < 4; ++m)
#pragma unroll
                    for (int n = 0; n < 2; ++n) acc[a][b][m][n] = (f32x4){0.f, 0.f, 0.f, 0.f};
        cur = nxt; cA = nA; cB = nB; ++ui;
        if constexpr (ALIGN_EPI) { if (wr == 1) PG8_BAR; }
    }
    PG8_WAIT_V(0);
    if constexpr (!ALIGN_EPI) { if (wr == 0) PG8_BAR; }
    PG8_BAR;
    if constexpr (Epi::AFTER_DRAIN) E.fused(acc, cur, wr, wc, fr, fq, lds, tid);
#undef PG8_SA
#undef PG8_SB
#undef PG8_STAGE
#undef PG8_LDA
#undef PG8_LDB
#undef PG8_MMA
#undef PG8_WAIT_V
#undef PG8_WAIT_L
#undef PG8_BAR
#undef PG8_SCHED
}
}

constexpr int NWAVES = 8;
constexpr int M = 65536, D = 1024, SEQ = 2048, BATCH = 32, DEPTH = 4;
constexpr int D_IN_SRC = 2064, NIN = 2304, DFF = 2816, NFF2 = 5632;
constexpr int ZBW = 1792;
constexpr int AEXT_LD = 384;
constexpr float EPS = 1e-6f;
constexpr size_t MiB = 1u << 20;
constexpr size_t WS_CTL = 0, CTL_ZERO_BYTES = 2 * MiB;
constexpr size_t WS_RS = 844 * MiB;
constexpr size_t WS_AT = 5 * MiB;
constexpr size_t WS_W1 = 6 * MiB, WS_WG = 24 * MiB, WS_WO = 26 * MiB, WS_WF1 = 34 * MiB, WS_WF2 = 78 * MiB, WS_WX = 100 * MiB, WS_WY = 116 * MiB;
constexpr size_t WS_XB = 140 * MiB;
constexpr size_t WS_HID = 268 * MiB;
constexpr size_t WS_AEXT = 620 * MiB;
constexpr size_t WS_XS = 716 * MiB;
constexpr size_t WS_YG = 780 * MiB;
constexpr size_t WS_END = 852 * MiB;
static_assert(WS_W1 + (size_t)DEPTH * NIN * D * 2 <= WS_WG && WS_WG + (size_t)DEPTH * 512 * 512 * 2 <= WS_WO && WS_WO + (size_t)DEPTH * D * D * 2 <= WS_WF1 &&
              WS_WF1 + (size_t)DEPTH * NFF2 * D * 2 <= WS_WF2 && WS_WF2 + (size_t)DEPTH * D * DFF * 2 <= WS_WX && WS_WX + (size_t)DEPTH * 32 * 256 * 256 * 2 <= WS_WY &&
              WS_WY + (size_t)DEPTH * 32 * 256 * 384 * 2 <= WS_XB && WS_XB + (size_t)M * D * 2 <= WS_HID && WS_HID + (size_t)M * DFF * 2 <= WS_AEXT &&
              WS_AEXT + (size_t)32 * 4096 * AEXT_LD * 2 <= WS_XS &&
              WS_XS + (size_t)32 * 4096 * 128 * 4 <= WS_YG && WS_YG + (size_t)M * 512 * 2 <= WS_RS && WS_RS + 13 * (size_t)M * 8 <= WS_END, "d_ws map");
constexpr size_t PANEL = (size_t)256 * DFF * 2;
constexpr size_t PANEL_AMIX = (size_t)16 * 57344;
constexpr size_t SLAB = 32 * PANEL;
constexpr int ZBLOB = 57344, ZB_GATE = 0, ZB_Q = 8192, ZB_K = 16384, ZB_V = 24576, ZB_G = 40960;
__device__ __forceinline__ size_t zb_blob(size_t row, int h) { const size_t b = row >> 11, n = (row >> 6) & 31; (void)b; return (row >> 8) * PANEL + (((n & 3) * 4 + (size_t)h) * (size_t)ZBLOB); }
__device__ __forceinline__ size_t amix_addr(size_t row, unsigned col) { return (row >> 8) * PANEL + PANEL_AMIX + (size_t)(col >> 6) * 32768 + (row & 255) * 128 + (col & 63) * 2; }
__device__ __forceinline__ unsigned yg_addr(unsigned token, unsigned col) { return (token >> 8) * 262144u + (col >> 6) * 32768u + (token & 255u) * 128u + (col & 63u) * 2u; }
__device__ __forceinline__ unsigned xb_off(unsigned row, unsigned col) { return (row >> 8) * 524288u + (col >> 6) * 32768u + (row & 255u) * 128u + (col & 63u) * 2u; }
constexpr int CW_BAR = 4096;
constexpr int RING_OFF = 0, RING_BYTES = 131072, LDSCTL_OFF = RING_BYTES, MISC_OFF = LDSCTL_OFF + 320, LDS_BYTES = 147456;

#define GAS __attribute__((address_space(1)))
#define LAS __attribute__((address_space(3)))
typedef unsigned short bf16;
typedef unsigned v4u __attribute__((ext_vector_type(4)));
typedef unsigned v2u __attribute__((ext_vector_type(2)));
typedef float f32x4 __attribute__((ext_vector_type(4)));
typedef short bf16x8 __attribute__((ext_vector_type(8)));
typedef short bf16x4 __attribute__((ext_vector_type(4)));
typedef GAS unsigned gu32;
#define RLX_AGENT __ATOMIC_RELAXED, __HIP_MEMORY_SCOPE_AGENT
#define LDS_WAIT() asm volatile("s_waitcnt lgkmcnt(0)" ::: "memory")
__device__ __forceinline__ unsigned f2bf(float f) { unsigned u = __builtin_bit_cast(unsigned, f); return (u + 0x7fffu + ((u >> 16) & 1u)) >> 16; }
__device__ __forceinline__ unsigned pk2(float lo, float hi) { return pg8::cvt_pk_bf16(lo, hi); }
__device__ __forceinline__ float bf_lo(unsigned w) { return __builtin_bit_cast(float, w << 16); }
__device__ __forceinline__ float bf_hi(unsigned w) { return __builtin_bit_cast(float, w & 0xffff0000u); }
__device__ __forceinline__ float bf2f(bf16 b) { return __builtin_bit_cast(float, ((unsigned)b) << 16); }
typedef unsigned long long u64;
__device__ __forceinline__ float rs_get(const u64* p, int row) { return (float)p[row] * (1.0f / 16777216.0f); }
__device__ __forceinline__ float rs_cvt(u64 v) { return (float)v * (1.0f / 16777216.0f); }
__device__ __forceinline__ void rs_get8(const u64* p, int row0, float (&o)[2][4]) {
    u64 raw[2][4];
#pragma unroll
    for (int ai = 0; ai < 2; ++ai)
#pragma unroll
        for (int m = 0; m < 4; ++m) raw[ai][m] = p[row0 + ai * 128 + m * 16];
    asm volatile("" ::: "memory");
#pragma unroll
    for (int ai = 0; ai < 2; ++ai)
#pragma unroll
        for (int m = 0; m < 4; ++m) o[ai][m] = rs_cvt(raw[ai][m]);
}
__device__ __forceinline__ void rs_add(u64* p, int row, float ss) { atomicAdd(p + row, (u64)(ss * 16777216.0f)); }
__device__ __forceinline__ float fsigmoid(float x) { return __builtin_amdgcn_rcpf(1.0f + __builtin_amdgcn_exp2f(-1.4426950409f * x)); }
__device__ __forceinline__ float gelu_tanh(float y) { const float z = y + 0.044715f * y * y * y; return y * __builtin_amdgcn_rcpf(1.0f + __builtin_amdgcn_exp2f(-2.3022081995f * z)); }

#define XB_TMO      128
#define XB_XCNT(j)  (256  + 64 * (j))
#define XB_XSUB(j)  (1280 + 64 * (j))
#define XB_XGEN(j)  (2304 + 64 * (j))
#define XB_TOP      3328
#define XB_TOPGEN   3392
#define XCD_BAR_WORDS 3456
#define XB_SPIN_CAP (1u << 18)
__device__ __forceinline__ unsigned xb_ld(unsigned* p)              { return __hip_atomic_load(p, __ATOMIC_RELAXED, __HIP_MEMORY_SCOPE_AGENT); }
__device__ __forceinline__ unsigned xb_add(unsigned* p, unsigned v) { return __hip_atomic_fetch_add(p, v, __ATOMIC_RELAXED, __HIP_MEMORY_SCOPE_AGENT); }
__device__ __forceinline__ unsigned xb_xcc_id() { return (unsigned)__builtin_amdgcn_s_getreg((3 << 11) | 20) & 0xFu; }
#define XB_SPIN(cond, bar) do { unsigned _sp = 0; while (cond) { __builtin_amdgcn_s_sleep(1); \
    if ((++_sp & 255u) == 0u) { if (xb_ld(&(bar)[XB_TMO])) break; if (_sp > XB_SPIN_CAP) { atomicAdd(&(bar)[XB_TMO], 1u); break; } } } } while (0)
struct XcdBarrier { unsigned* bar; unsigned x; volatile LAS unsigned* st; unsigned G; };
__device__ __forceinline__ XcdBarrier xcd_barrier_post(unsigned* bar, volatile LAS unsigned* st, unsigned G) {
    XcdBarrier b; b.bar = bar; b.x = xb_xcc_id(); b.st = st; b.G = G;
    if (threadIdx.x == 0) (void)xb_add(&bar[XB_XCNT(b.x)], 1u);
    return b;
}
__device__ __forceinline__ void xcd_barrier_complete(unsigned* bar, unsigned x, unsigned& nloc, unsigned& nx, const unsigned G) {
    unsigned sum, cnt, mine, sp = 0u;
    for (;;) {
        sum = 0u; cnt = 0u; mine = 0u;
#pragma unroll
        for (unsigned j = 0; j < 16; ++j) { const unsigned c = xb_ld(&bar[XB_XCNT(j)]); sum += c; cnt += (c > 0u) ? 1u : 0u; mine = (j == x) ? c : mine; }
        if (sum == G) break;
        __builtin_amdgcn_s_sleep(1);
        if ((++sp & 255u) == 0u) { if (xb_ld(&bar[XB_TMO])) break; if (sp > XB_SPIN_CAP) { atomicAdd(&bar[XB_TMO], 1u); break; } }
    }
    nloc = mine > 0u ? mine : 1u; nx = cnt > 0u ? cnt : 1u;
}
__device__ __forceinline__ void xcd_barrier(const XcdBarrier& b) {
    asm volatile("s_waitcnt vmcnt(0)" ::: "memory");
    __syncthreads();
    if (threadIdx.x == 0) {
        unsigned* bar = b.bar;
        __builtin_amdgcn_s_waitcnt(0);
        unsigned nloc = b.st[0], nx = b.st[1];
        if (nloc == 0u) { xcd_barrier_complete(bar, b.x, nloc, nx, b.G); b.st[0] = nloc; b.st[1] = nx; }
        const unsigned old = xb_add(&bar[XB_XSUB(b.x)], 1u);
        const unsigned gen = old / nloc;
        if (old + 1u == (gen + 1u) * nloc) {
            __builtin_amdgcn_fence(__ATOMIC_RELEASE, "agent");
            asm volatile("s_waitcnt vmcnt(0)" ::: "memory");
            const unsigned og = xb_add(&bar[XB_TOP], 1u);
            const unsigned tg = og / nx;
            if (og + 1u == (tg + 1u) * nx) xb_add(&bar[XB_TOPGEN], 1u);
            else XB_SPIN(xb_ld(&bar[XB_TOPGEN]) == tg, bar);
            __builtin_amdgcn_fence(__ATOMIC_ACQUIRE, "agent");
            xb_add(&bar[XB_XGEN(b.x)], 1u);
            asm volatile("s_waitcnt vmcnt(0)" ::: "memory");
        } else {
            XB_SPIN(xb_ld(&bar[XB_XGEN(b.x)]) == gen, bar);
            __builtin_amdgcn_fence(__ATOMIC_ACQUIRE, "agent");
            asm volatile("s_waitcnt vmcnt(0)" ::: "memory");
        }
    }
    __syncthreads();
}

using pg8::Unit;

typedef float f2p __attribute__((ext_vector_type(2)));
__device__ __forceinline__ f32x4 swish4(f32x4 v) {
    const f2p a = {v[0], v[1]}, b = {v[2], v[3]}; const f2p ta = a * (f2p){-1.4426950409f, -1.4426950409f}, tb = b * (f2p){-1.4426950409f, -1.4426950409f};
    f2p ea, eb; ea.x = __builtin_amdgcn_exp2f(ta.x); ea.y = __builtin_amdgcn_exp2f(ta.y); eb.x = __builtin_amdgcn_exp2f(tb.x); eb.y = __builtin_amdgcn_exp2f(tb.y);
    const f2p da = ea + (f2p){1.0f, 1.0f}, db = eb + (f2p){1.0f, 1.0f}; f2p ra, rb; ra.x = __builtin_amdgcn_rcpf(da.x); ra.y = __builtin_amdgcn_rcpf(da.y); rb.x = __builtin_amdgcn_rcpf(db.x); rb.y = __builtin_amdgcn_rcpf(db.y);
    const f2p ya = a * ra, yb = b * rb; return (f32x4){ya.x, ya.y, yb.x, yb.y};
}
struct EpiIn { static constexpr int KSCALE_T = -1; static constexpr bool AFTER_DRAIN = false; static constexpr bool PERM = true;
    const u64* rowsq; bf16* aext; bf16* zb;
    template <bool SW = false> __device__ __forceinline__ void store_all(const f32x4 (&acc)[2][2][4][2], const float (&rsv)[2][4], char* base, unsigned c0, unsigned c1, unsigned sa, unsigned sm, int wr) const {
#pragma unroll
        for (int ai = 0; ai < 2; ++ai)
#pragma unroll
            for (int m = 0; m < 4; ++m) { const float rs = rsqrtf(rsv[ai][m] * (1.0f / D) + EPS); const unsigned up = (unsigned)(2 * ai + wr) * sa + (unsigned)m * sm;
#pragma unroll
                for (int bj = 0; bj < 2; ++bj) { f32x4 v0 = acc[ai][bj][m][0] * rs, v1 = acc[ai][bj][m][1] * rs;
                    if (SW) { v0 = swish4(v0); v1 = swish4(v1); }
                    v4u w; w.x = pk2(v0[0], v0[1]); w.y = pk2(v0[2], v0[3]); w.z = pk2(v1[0], v1[1]); w.w = pk2(v1[2], v1[3]);
                    *(v4u*)(base + ((bj ? c1 : c0) + up)) = w; }
                asm volatile("" ::: "memory"); }
    }
    __device__ __forceinline__ void operator()(const f32x4 (&acc)[2][2][4][2], const Unit& u, int wr, int wc, int fr, int fq) const {
        const int row0 = u.pm * 256 + wr * 64 + fr, cb = wc * 32 + 8 * fq;
        float rsv[2][4]; rs_get8(rowsq, row0, rsv);
        const int b = u.pm >> 3, p7 = u.pm & 7;
        if (u.pn < 2) {
            const int col0 = u.pn * 256 + cb, col1 = col0 + 128;
            const unsigned c0 = (unsigned)(((col0 >> 4) * 4096 + b * 128 + p7 * 16) * AEXT_LD + fr * 16 + (col0 & 15)) * 2u, c1 = (unsigned)(((col1 >> 4) * 4096 + b * 128 + p7 * 16) * AEXT_LD + fr * 16 + (col1 & 15)) * 2u;
            store_all(acc, rsv, (char*)aext, c0, c1, 4 * AEXT_LD * 2, AEXT_LD * 2, wr);
        } else {
            const bool wide = (u.pn >= 4 && u.pn <= 7); const int pitch = wide ? 256 : 128;
            const int aoff = (u.pn == 2) ? ZB_Q : (u.pn == 3) ? ZB_K : (u.pn < 6) ? ZB_V : (u.pn < 8) ? ZB_G : ZB_GATE;
            unsigned cc[2];
#pragma unroll
            for (int bj = 0; bj < 2; ++bj) { const int ct = bj * 128 + cb, hc = wide ? ((u.pn & 1) * 256 + ct) : ct; const int h = wide ? (hc >> 7) : (hc >> 6), c = wide ? (hc & 127) : (hc & 63);
                cc[bj] = (unsigned)(h * ZBLOB + aoff + c * 2 + fr * pitch); }
            if (u.pn == 6 || u.pn == 7) store_all<true>(acc, rsv, (char*)zb + (size_t)u.pm * PANEL, cc[0], cc[1], 4 * ZBLOB, 16 * pitch, wr);
            else store_all(acc, rsv, (char*)zb + (size_t)u.pm * PANEL, cc[0], cc[1], 4 * ZBLOB, 16 * pitch, wr);
        }
    }
};
struct FourUnits { int pm0, gx;
    __device__ __forceinline__ bool next(int i, Unit& u) const { if (i > 3) return false; const int idx = pm0 + i; u.pm = (idx >> 1) * 16 + 2 * gx + (idx & 1); u.pn = 0; return true; }
    __device__ __forceinline__ void a_ready(const Unit&) const {}
    __device__ __forceinline__ void done(const Unit&) const {}
};
struct OneUnit { int pm;
    __device__ __forceinline__ bool next(int i, Unit& u) const { if (i > 0) return false; u.pm = pm; u.pn = 0; return true; }
    __device__ __forceinline__ void a_ready(const Unit&) const {}
    __device__ __forceinline__ void done(const Unit&) const {}
};
struct EpiXS { static constexpr int KSCALE_T = -1; static constexpr bool AFTER_DRAIN = true; static constexpr bool PERM = false;
    const float2* at; bf16* aext;
    __device__ __forceinline__ void fused(const f32x4 (&acc)[2][2][4][2], const Unit& u, int wr, int wc, int fr, int fq, LAS unsigned char* lds, int tid) const {
        LAS float* X = (LAS float*)lds;
#pragma unroll
        for (int ai = 0; ai < 2; ++ai)
#pragma unroll
            for (int m = 0; m < 4; ++m) { const int r = ai * 128 + wr * 64 + m * 16 + fr;
#pragma unroll
                for (int n = 0; n < 2; ++n) { const int ch = (8 * wc + 4 * n + fq) ^ (r & 7); *(LAS f32x4*)(X + r * 128 + ch * 4) = acc[ai][0][m][n]; } }
        __syncthreads();
        const int sq = tid & 127, qd = tid >> 7, bb = sq >> 6, p = sq & 63, g = u.pm >> 4, bp = u.pm & 15;
        const float2 A = at[g * 64 + p];
        typedef float f2v __attribute__((ext_vector_type(2)));
        LAS f2v* T = (LAS f2v*)(lds + RING_BYTES + 1024);
        const int r0 = bb * 128 + 32 * qd;
#define XS_AT(row, col) X[(row) * 128 + ((((col) >> 2) ^ ((row) & 7)) << 2) + ((col) & 3)]
        float sr = 0.f, si = 0.f;
#pragma unroll 8
        for (int c = 0; c < 32; ++c) { const float xr = XS_AT(r0 + c, p), xi = XS_AT(r0 + c, 64 + p); const float nr = A.x * sr - A.y * si + xr, ni = A.x * si + A.y * sr + xi; sr = nr; si = ni; }
        T[qd * 128 + sq] = (f2v){sr, si};
        __syncthreads();
        float2 A32 = A;
#pragma unroll
        for (int k = 0; k < 5; ++k) A32 = make_float2(A32.x * A32.x - A32.y * A32.y, 2.0f * A32.x * A32.y);
        sr = 0.f; si = 0.f;
        for (int q2 = 0; q2 < qd; ++q2) { const f2v t = T[q2 * 128 + sq]; const float nr = A32.x * sr - A32.y * si + t.x, ni = A32.x * si + A32.y * sr + t.y; sr = nr; si = ni; }
        bf16* ae = aext + ((size_t)g * 4096 + (size_t)(2 * bp + bb) * 128 + 32 * qd) * AEXT_LD + 256 + p;
#pragma unroll 8
        for (int c = 0; c < 32; ++c) { ae[(size_t)c * AEXT_LD] = (bf16)f2bf(sr); ae[(size_t)c * AEXT_LD + 64] = (bf16)f2bf(si);
            const float xr = XS_AT(r0 + c, p), xi = XS_AT(r0 + c, 64 + p); const float nr = A.x * sr - A.y * si + xr, ni = A.x * si + A.y * sr + xi; sr = nr; si = ni; }
#undef XS_AT
        asm volatile("s_waitcnt vmcnt(0)" ::: "memory");
        __syncthreads();
        if (tid == 0) { __builtin_amdgcn_fence(__ATOMIC_ACQUIRE, "agent"); asm volatile("s_waitcnt vmcnt(0)" ::: "memory"); }
        __syncthreads();
    }
};
struct EpiY { static constexpr int KSCALE_T = -1; static constexpr bool AFTER_DRAIN = false; static constexpr bool PERM = true;
    bf16* yg;
    __device__ __forceinline__ void operator()(const f32x4 (&acc)[2][2][4][2], const Unit& u, int wr, int wc, int fr, int fq) const {
        const int row0 = u.pm * 256 + wr * 64 + fr, cb = wc * 32 + 8 * fq;
        const int g = row0 >> 12;
        const unsigned cpart = (unsigned)(g >> 2) * 32768u + (unsigned)((g & 3) * 16 + (cb & 15)) * 2u;
        char* base = (char*)yg;
#pragma unroll
        for (int ai = 0; ai < 2; ++ai)
#pragma unroll
            for (int m = 0; m < 4; ++m) { const int R = row0 + ai * 128 + m * 16; const unsigned tok0 = (unsigned)(((R >> 7) & 31) * SEQ + (R & 127) * 16);
#pragma unroll
                for (int bj = 0; bj < 2; ++bj) { const f32x4 a0 = acc[ai][bj][m][0], a1 = acc[ai][bj][m][1]; const unsigned token = tok0 + (unsigned)((bj * 128 + cb) >> 4);
                    v4u w; w.x = pk2(gelu_tanh(a0[0]), gelu_tanh(a0[1])); w.y = pk2(gelu_tanh(a0[2]), gelu_tanh(a0[3])); w.z = pk2(gelu_tanh(a1[0]), gelu_tanh(a1[1])); w.w = pk2(gelu_tanh(a1[2]), gelu_tanh(a1[3]));
                    *(v4u*)(base + ((token >> 8) * 262144u + (token & 255u) * 128u + cpart)) = w; }
                asm volatile("" ::: "memory"); }
    }
};
struct EpiGlu { static constexpr int KSCALE_T = -1; static constexpr bool AFTER_DRAIN = false; static constexpr bool PERM = true;
    const bf16* yg; const float* bias; bf16* amix; u64* rs5; float zm;
    __device__ __forceinline__ void operator()(const f32x4 (&acc)[2][2][4][2], const Unit& u, int wr, int wc, int fr, int fq) const {
        const int row0 = u.pm * 256 + wr * 64 + fr, cb = u.pn * 256 + wc * 32 + 8 * fq;
        f32x4 bv[2][2];
#pragma unroll
        for (int bj = 0; bj < 2; ++bj)
#pragma unroll
            for (int n = 0; n < 2; ++n) bv[bj][n] = *(const f32x4*)(bias + cb + bj * 128 + 4 * n);
#pragma unroll
        for (int ai = 0; ai < 2; ++ai) {
            v4u yv[4][2];
#pragma unroll
            for (int m = 0; m < 4; ++m)
#pragma unroll
                for (int bj = 0; bj < 2; ++bj) yv[m][bj] = *(const v4u*)((const char*)yg + yg_addr((unsigned)(row0 + ai * 128 + m * 16), (unsigned)(cb + bj * 128)));
            asm volatile("" ::: "memory");
#pragma unroll
            for (int m = 0; m < 4; ++m) { const int row = row0 + ai * 128 + m * 16; float ss = 0.f;
#pragma unroll
                for (int bj = 0; bj < 2; ++bj) { const int col = cb + bj * 128; const v4u yq = yv[m][bj];
                    const f32x4 p0 = acc[ai][bj][m][0] + bv[bj][0], p1 = acc[ai][bj][m][1] + bv[bj][1];
                    const float y0 = bf_lo(yq.x) * fsigmoid(p0[0]), y1 = bf_hi(yq.x) * fsigmoid(p0[1]), y2 = bf_lo(yq.y) * fsigmoid(p0[2]), y3 = bf_hi(yq.y) * fsigmoid(p0[3]);
                    const float y4 = bf_lo(yq.z) * fsigmoid(p1[0]), y5 = bf_hi(yq.z) * fsigmoid(p1[1]), y6 = bf_lo(yq.w) * fsigmoid(p1[2]), y7 = bf_hi(yq.w) * fsigmoid(p1[3]);
                    ss += (y0 * y0 + y1 * y1) + (y2 * y2 + y3 * y3) + (y4 * y4 + y5 * y5) + (y6 * y6 + y7 * y7);
                    v4u w; w.x = pk2(y0, y1); w.y = pk2(y2, y3); w.z = pk2(y4, y5); w.w = pk2(y6, y7);
                    *(v4u*)((char*)amix + amix_addr((size_t)row, (unsigned)col)) = w; }
                ss += __shfl_xor(ss, 16); ss += __shfl_xor(ss, 32);
                if (fq == 0) rs_add(rs5, row, ss * zm); }
            asm volatile("" ::: "memory"); }
    }
};
template <bool KS> struct EpiRes { static constexpr int KSCALE_T = KS ? 6 : -1; static constexpr bool AFTER_DRAIN = false; static constexpr bool PERM = true;
    bf16* xb; const u64* rs_in; u64* rs_out; float zm;
    __device__ __forceinline__ void kscale(f32x4 (&acc)[2][2][4][2], const Unit& u, int wr, int fr) const {
        const int row0 = u.pm * 256 + wr * 64 + fr; float sv[2][4]; rs_get8(rs_in, row0, sv);
#pragma unroll
        for (int ai = 0; ai < 2; ++ai)
#pragma unroll
            for (int m = 0; m < 4; ++m) { const float sc = rsqrtf(sv[ai][m] * (1.0f / 512.0f) + EPS);
#pragma unroll
                for (int bj = 0; bj < 2; ++bj)
#pragma unroll
                    for (int n = 0; n < 2; ++n) acc[ai][bj][m][n] = acc[ai][bj][m][n] * sc; }
    }
    __device__ __forceinline__ void operator()(const f32x4 (&acc)[2][2][4][2], const Unit& u, int wr, int wc, int fr, int fq) const {
        const int row0 = u.pm * 256 + wr * 64 + fr, cb = u.pn * 256 + wc * 32 + 8 * fq;
        char* xbb = (char*)xb;
        const float sc = zm;
#pragma unroll
        for (int ai = 0; ai < 2; ++ai) { float ssm[4];
            v4u xv[4][2];
#pragma unroll
            for (int m = 0; m < 4; ++m)
#pragma unroll
                for (int bj = 0; bj < 2; ++bj) xv[m][bj] = *(const v4u*)(xbb + xb_off((unsigned)(row0 + ai * 128 + m * 16), (unsigned)(cb + bj * 128)));
            asm volatile("" ::: "memory");
#pragma unroll
            for (int m = 0; m < 4; ++m) { const int row = row0 + ai * 128 + m * 16; float ss = 0.f;
#pragma unroll
                for (int bj = 0; bj < 2; ++bj) { const v4u xq = xv[m][bj]; const f32x4 a0 = acc[ai][bj][m][0] * sc, a1 = acc[ai][bj][m][1] * sc;
                    v4u w; w.x = pk2(bf_lo(xq.x) + a0[0], bf_hi(xq.x) + a0[1]); w.y = pk2(bf_lo(xq.y) + a0[2], bf_hi(xq.y) + a0[3]); w.z = pk2(bf_lo(xq.z) + a1[0], bf_hi(xq.z) + a1[1]); w.w = pk2(bf_lo(xq.w) + a1[2], bf_hi(xq.w) + a1[3]);
                    *(v4u*)(xbb + xb_off((unsigned)row, (unsigned)(cb + bj * 128))) = w;
                    const float r0 = bf_lo(w.x), r1 = bf_hi(w.x), r2 = bf_lo(w.y), r3 = bf_hi(w.y), r4 = bf_lo(w.z), r5 = bf_hi(w.z), r6 = bf_lo(w.w), r7 = bf_hi(w.w);
                    ss += (r0 * r0 + r1 * r1) + (r2 * r2 + r3 * r3) + (r4 * r4 + r5 * r5) + (r6 * r6 + r7 * r7); }
                ss += __shfl_xor(ss, 16); ss += __shfl_xor(ss, 32); ssm[m] = ss; }
            const float mine = (fq == 0) ? ssm[0] : (fq == 1) ? ssm[1] : (fq == 2) ? ssm[2] : ssm[3];
            rs_add(rs_out, row0 + ai * 128 + fq * 16, mine * zm);
            asm volatile("" ::: "memory"); }
    }
};
struct EpiFfn { static constexpr int KSCALE_T = -1; static constexpr bool AFTER_DRAIN = false; static constexpr bool PERM = true;
    const u64* rowsq; bf16* hid; mutable float rsv[2][4]; mutable int cpm;
    __device__ __forceinline__ void operator()(const f32x4 (&acc)[2][2][4][2], const Unit& u, int wr, int wc, int fr, int fq) const {
        const int row0 = u.pm * 256 + wr * 64 + fr, cb = u.pn * 128 + wc * 32 + 8 * fq;
        if (u.pm != cpm) { rs_get8(rowsq, row0, rsv); cpm = u.pm; }
#pragma unroll
        for (int ai = 0; ai < 2; ++ai)
#pragma unroll
            for (int m = 0; m < 4; ++m) { const int row = row0 + ai * 128 + m * 16; const float rs = rsqrtf(rsv[ai][m] * (1.0f / D) + EPS);
                typedef float f2p __attribute__((ext_vector_type(2)));
                const float rsn = rs * -1.4426950409f, rs2 = rs * rs; const f2p rsn2 = {rsn, rsn}, rsq2 = {rs2, rs2}, one2 = {1.0f, 1.0f};
                unsigned hw[4];
#pragma unroll
                for (int n = 0; n < 2; ++n)
#pragma unroll
                    for (int j = 0; j < 2; ++j) { const f2p g2 = {acc[ai][0][m][n][2 * j], acc[ai][0][m][n][2 * j + 1]}, u2 = {acc[ai][1][m][n][2 * j], acc[ai][1][m][n][2 * j + 1]};
                        const f2p t2 = g2 * rsn2; f2p e2; e2.x = __builtin_amdgcn_exp2f(t2.x); e2.y = __builtin_amdgcn_exp2f(t2.y);
                        const f2p d2 = e2 + one2; f2p r2; r2.x = __builtin_amdgcn_rcpf(d2.x); r2.y = __builtin_amdgcn_rcpf(d2.y);
                        const f2p h2 = ((g2 * u2) * rsq2) * r2; hw[2 * n + j] = pk2(h2.x, h2.y); }
                v4u w; w.x = hw[0]; w.y = hw[1]; w.z = hw[2]; w.w = hw[3];
                *(v4u*)((char*)hid + (size_t)(row >> 8) * ((size_t)256 * DFF * 2) + (size_t)(cb >> 6) * (256 * 128) + (size_t)(row & 255) * 128 + (cb & 63) * 2) = w;
                asm volatile("" ::: "memory"); }
    }
};

struct Args { const float* in[22]; float* out; unsigned char* ws; int ph_lo, ph_hi; };
typedef const Args __attribute__((address_space(4)))* KArgs;
__device__ __forceinline__ KArgs kargs() { KArgs p = (KArgs)__builtin_amdgcn_kernarg_segment_ptr(); asm volatile("" : "+s"(p)); return p; }
enum { I_X = 0, I_NORM_MIX, I_W_IN, I_LAM_RE, I_LAM_IM, I_B_RE, I_B_IM, I_C_RE, I_C_IM, I_S5D, I_LOGSTEP, I_WGLU, I_BGLU, I_S5NORM, I_WGATE, I_BGATE, I_GLANORM, I_WOUT, I_NORM_FFN, I_WFFN_IN, I_WFFN_OUT, I_NORM_FINAL };

__device__ __forceinline__ float wave_sum(float v) {
#pragma unroll
    for (int o = 1; o < 64; o <<= 1) v += __shfl_xor(v, o);
    return v;
}
__device__ __forceinline__ void transpose_item(const float* W, int ldn, int k0, int nsrc0, bf16* WT, int ldk, int ndst0, const float* scale, LAS float* scr, int lane) {
    float wv[32], sv[32];
#pragma unroll
    for (int i = 0; i < 32; ++i) { const int kk = 2 * i + (lane >> 5); wv[i] = W[(size_t)(k0 + kk) * ldn + nsrc0 + (lane & 31)]; sv[i] = scale ? scale[k0 + kk] : 1.0f; }
#pragma unroll
    for (int i = 0; i < 32; ++i) { const int kk = 2 * i + (lane >> 5); scr[kk * 33 + (lane & 31)] = wv[i] * sv[i]; }
    LDS_WAIT(); asm volatile("" ::: "memory");
    const int c = lane & 7;
#pragma unroll
    for (int j = 0; j < 4; ++j) { const int n = (lane >> 3) + 8 * j; const LAS float* s = scr + (8 * c) * 33 + n;
        v4u o; o.x = pk2(s[0 * 33], s[1 * 33]); o.y = pk2(s[2 * 33], s[3 * 33]); o.z = pk2(s[4 * 33], s[5 * 33]); o.w = pk2(s[6 * 33], s[7 * 33]);
        *(GAS v4u*)(WT + (size_t)(ndst0 + n) * ldk + k0 + 8 * c) = o; }
    LDS_WAIT(); asm volatile("" ::: "memory");
}

__device__ __forceinline__ void s5_tables(LAS unsigned char* lds, KArgs a, int l, int g, int half, int tid) {
    typedef double d2 __attribute__((ext_vector_type(2))); typedef float f2 __attribute__((ext_vector_type(2)));
    LAS d2* ap = (LAS d2*)lds;
    LAS f2* apf = (LAS f2*)(lds + 17408);
    LAS f2* Bb = (LAS f2*)(lds + 17408 + 8704);
    LAS f2* Cc = (LAS f2*)(lds + 17408 + 8704 + 8192);
    LAS float* Kt = (LAS float*)(lds + 17408 + 8704 + 16384);
    const int lg = l * 32 + g;
    const double step = exp((double)a->in[I_LOGSTEP][lg]);
    const float* lre = a->in[I_LAM_RE] + lg * 64; const float* lim = a->in[I_LAM_IM] + lg * 64;
    for (int i = tid; i < 64 * 17; i += 512) { const int p = i / 17, dl = i % 17; const double lr = lre[p], li = lim[p]; const double mag = exp(lr * step * dl), ang = li * step * dl; const d2 v = (d2){mag * cos(ang), mag * sin(ang)}; ap[i] = v; apf[i] = (f2){(float)v.x, (float)v.y}; }
    for (int i = tid; i < 1024; i += 512) { const int p = i >> 4; const double lr = lre[p], li = lim[p]; const double mag = exp(lr * step), ar = mag * cos(li * step), ai = mag * sin(li * step), den = lr * lr + li * li;
        const double fr = ((ar - 1.0) * lr + ai * li) / den, fi = (ai * lr - (ar - 1.0) * li) / den; const double br = a->in[I_B_RE][(size_t)lg * 1024 + i], bi = a->in[I_B_IM][(size_t)lg * 1024 + i];
        Bb[i] = (f2){(float)(fr * br - fi * bi), (float)(fr * bi + fi * br)}; }
    for (int i = tid; i < 1024; i += 512) Cc[i] = (f2){a->in[I_C_RE][(size_t)lg * 1024 + i], a->in[I_C_IM][(size_t)lg * 1024 + i]};
    __syncthreads();
    for (int i = tid; i < 2048; i += 512) { const int dl = i >> 7, h = 8 * half + ((i >> 4) & 7), hp = i & 15; float s = 0.f;
#pragma unroll 8
        for (int p = 0; p < 64; ++p) { const f2 c = Cc[h * 64 + p], av = apf[p * 17 + dl], bv = Bb[p * 16 + hp]; const float cr = c.x * av.x - c.y * av.y, ci = c.x * av.y + c.y * av.x; s += cr * bv.x - ci * bv.y; }
        if (dl == 0 && h == hp) s += a->in[I_S5D][l * 512 + g * 16 + h];
        Kt[dl * 256 + h * 16 + hp] = s; }
    __syncthreads();
    bf16* wx = (bf16*)(a->ws + WS_WX) + (size_t)lg * 256 * 256; bf16* wy = (bf16*)(a->ws + WS_WY) + (size_t)lg * 256 * 384;
    for (int i = tid; i < 128 * 32; i += 512) { const int nl = i >> 5, k0 = (i & 31) * 8; const int n = (nl & 63) + 64 * half + 128 * (nl >> 6); v4u o = (v4u){0u, 0u, 0u, 0u};
        if (n < 128) { const int p = n & 63, im = n >> 6; float v[8];
#pragma unroll
            for (int e = 0; e < 8; ++e) { const int k = k0 + e, tau = k >> 4, hp = k & 15; const f2 av = apf[p * 17 + 15 - tau], bv = Bb[p * 16 + hp]; v[e] = im ? (av.x * bv.y + av.y * bv.x) : (av.x * bv.x - av.y * bv.y); }
            o.x = pk2(v[0], v[1]); o.y = pk2(v[2], v[3]); o.z = pk2(v[4], v[5]); o.w = pk2(v[6], v[7]); }
        *(v4u*)(wx + (size_t)n * 256 + k0) = o; }
    for (int i = tid; i < 128 * 48; i += 512) { const int nl = i / 48, k0 = (i % 48) * 8, t = nl >> 3, h = 8 * half + (nl & 7), n = t * 16 + h; float v[8];
#pragma unroll
        for (int e = 0; e < 8; ++e) { const int k = k0 + e;
            if (k < 256) { const int tau = k >> 4, hp = k & 15; v[e] = (tau <= t) ? Kt[(t - tau) * 256 + h * 16 + hp] : 0.0f; }
            else { const int p = (k - 256) & 63, im = (k - 256) >> 6; const f2 c = Cc[h * 64 + p], av = apf[p * 17 + t + 1]; v[e] = im ? -(c.x * av.y + c.y * av.x) : (c.x * av.x - c.y * av.y); } }
        v4u o; o.x = pk2(v[0], v[1]); o.y = pk2(v[2], v[3]); o.z = pk2(v[4], v[5]); o.w = pk2(v[6], v[7]);
        *(v4u*)(wy + (size_t)n * 384 + k0) = o; }
    if (half == 0 && tid < 64) { const d2 av = ap[tid * 17 + 16]; ((float2*)(a->ws + WS_AT))[lg * 64 + tid] = make_float2((float)av.x, (float)av.y); }
    __syncthreads();
}

__device__ __forceinline__ void p0_prologue(LAS unsigned char* lds, KArgs a, int tid, int lane, int wave) {
    asm volatile("" : "+v"(tid), "+v"(lane));
    const int G = gridDim.x, gw = blockIdx.x * NWAVES + wave, NGW = G * NWAVES;
    const bool tables_first = ((blockIdx.x >> 3) & 1) != 0;
    if (tables_first) for (int it = blockIdx.x; it < DEPTH * 32 * 2; it += G) s5_tables(lds, a, it >> 6, (it >> 1) & 31, it & 1, tid);
    LAS float* scr = (LAS float*)(lds + RING_OFF + wave * 16384);
    constexpr int IT_IN = 16 * 64, IT_GLU = 8 * 16, IT_OUT = 16 * 32, IT_F1 = 16 * 176, IT_F2 = 44 * 32, IT_L = IT_IN + IT_GLU + IT_OUT + IT_F1 + IT_F2;
    for (int it = gw; it < DEPTH * IT_L; it += NGW) {
        const int l = it / IT_L; int r = it % IT_L;
        if (r < IT_IN) { const int kb = r >> 6, nb = r & 63; transpose_item(a->in[I_W_IN] + (size_t)l * D * D_IN_SRC, D_IN_SRC, 64 * kb, 32 * nb, (bf16*)(a->ws + WS_W1) + (size_t)l * NIN * D, D, 32 * nb, a->in[I_NORM_MIX] + l * D, scr, lane); continue; } r -= IT_IN;
        if (r < IT_GLU) { const int kb = r >> 4, nb = r & 15; transpose_item(a->in[I_WGLU] + (size_t)l * 512 * 512, 512, 64 * kb, 32 * nb, (bf16*)(a->ws + WS_WG) + (size_t)l * 512 * 512, 512, 32 * nb, nullptr, scr, lane); continue; } r -= IT_GLU;
        if (r < IT_OUT) { const int kb = r >> 5, nb = r & 31; const float* sc = (kb < 8) ? (a->in[I_S5NORM] + l * 512) : (a->in[I_GLANORM] + l * 512 - 512);
            transpose_item(a->in[I_WOUT] + (size_t)l * D * D, D, 64 * kb, 32 * nb, (bf16*)(a->ws + WS_WO) + (size_t)l * D * D, D, 32 * nb, sc, scr, lane); continue; } r -= IT_OUT;
        if (r < IT_F1) { const int kb = r / 176, nb = r % 176; const int nd = 32 * nb, pn = nd >> 8, bj = (nd >> 7) & 1, c0 = nd & 127; const int ns = bj * DFF + 128 * pn + c0;
            transpose_item(a->in[I_WFFN_IN] + (size_t)l * D * NFF2, NFF2, 64 * kb, ns, (bf16*)(a->ws + WS_WF1) + (size_t)l * NFF2 * D, D, nd, a->in[I_NORM_FFN] + l * D, scr, lane); continue; } r -= IT_F1;
        { const int kb = r >> 5, nb = r & 31; transpose_item(a->in[I_WFFN_OUT] + (size_t)l * DFF * D, D, 64 * kb, 32 * nb, (bf16*)(a->ws + WS_WF2) + (size_t)l * D * DFF, DFF, 32 * nb, nullptr, scr, lane); }
    }
    for (int it = blockIdx.x * 512 + tid; it < DEPTH * 256 * 128; it += G * 512) { const int l = it >> 15, n = (it >> 7) & 255, k0 = (it & 127) * 8;
        float wg[16];
#pragma unroll
        for (int r = 0; r < 16; ++r) wg[r] = a->in[I_WGATE][(size_t)l * 16 * 256 + r * 256 + n];
        float v[8];
#pragma unroll
        for (int e = 0; e < 8; ++e) { const float* wr = a->in[I_W_IN] + ((size_t)l * D + k0 + e) * D_IN_SRC + 2048; float s = 0.f;
#pragma unroll
            for (int r = 0; r < 16; ++r) s += wr[r] * wg[r];
            v[e] = s * a->in[I_NORM_MIX][l * D + k0 + e]; }
        v4u o; o.x = pk2(v[0], v[1]); o.y = pk2(v[2], v[3]); o.z = pk2(v[4], v[5]); o.w = pk2(v[6], v[7]);
        *(v4u*)((bf16*)(a->ws + WS_W1) + ((size_t)l * NIN + 2048 + n) * D + k0) = o; }
    u64* rs = (u64*)(a->ws + WS_RS);
    for (int m = gw; m < M; m += 4 * NGW) {
        f32x4 v[4][4];
#pragma unroll
        for (int r = 0; r < 4; ++r) { const GAS f32x4* xr = (const GAS f32x4*)(a->in[I_X] + (size_t)(m + r * NGW) * D) + lane;
#pragma unroll
            for (int j = 0; j < 4; ++j) v[r][j] = xr[64 * j]; }
#pragma unroll
        for (int r = 0; r < 4; ++r) { float s = 0.f; GAS char* ob = (GAS char*)(a->ws + WS_XB);
#pragma unroll
            for (int j = 0; j < 4; ++j) { const v2u w = (v2u){pk2(v[r][j].x, v[r][j].y), pk2(v[r][j].z, v[r][j].w)}; *(GAS v2u*)(ob + xb_off((unsigned)(m + r * NGW), (unsigned)(4 * lane + 256 * j))) = w; const float r0 = bf_lo(w.x), r1 = bf_hi(w.x), r2 = bf_lo(w.y), r3 = bf_hi(w.y); s += (r0 * r0 + r1 * r1) + (r2 * r2 + r3 * r3); }
            s = wave_sum(s);
            if (lane == 0) rs[m + r * NGW] = (u64)(s * 16777216.0f); } }
    for (size_t i = (size_t)blockIdx.x * 512 + tid; i < (size_t)12 * M / 2; i += (size_t)G * 512) ((v4u*)(rs + M))[i] = (v4u){0u, 0u, 0u, 0u};
    if (!tables_first) { __syncthreads(); for (int it = blockIdx.x; it < DEPTH * 32 * 2; it += G) s5_tables(lds, a, it >> 6, (it >> 1) & 31, it & 1, tid); }
}

constexpr int GP = 72;
constexpr int GL_QD = 0, GL_KI = 9216, GL_KET = 18432, GL_VT = 27648, GL_P = 46080, GL_DEC = 55296, GL_PS = 55552, GL_OW = 57600, GL_OWP = 20;
template <int CTRL, int ROWMASK> __device__ __forceinline__ float dpp0(float v) { return __builtin_bit_cast(float, __builtin_amdgcn_update_dpp(0, __builtin_bit_cast(int, v), CTRL, ROWMASK, 0xF, false)); }
__device__ __forceinline__ float wave_incl_scan(float v) {
    v += dpp0<0x111, 0xF>(v); v += dpp0<0x112, 0xF>(v); v += dpp0<0x114, 0xF>(v); v += dpp0<0x118, 0xF>(v);
    v += dpp0<0x142, 0xA>(v); v += dpp0<0x143, 0xC>(v); return v;
}
struct GlaIn { v4u gt, q, k, v0, v1, g0, g1; };
__device__ __forceinline__ void gla_load(GlaIn& x, const bf16* zb, size_t token, int h, int w) {
    const char* zr = (const char*)zb + zb_blob(token, h); const int tl = (int)(token & 63);
    x.gt = *(const v4u*)(zr + ZB_GATE + tl * 128 + 16 * w); x.q = *(const v4u*)(zr + ZB_Q + tl * 128 + 16 * w); x.k = *(const v4u*)(zr + ZB_K + tl * 128 + 16 * w);
    x.v0 = *(const v4u*)(zr + ZB_V + tl * 256 + 32 * w); x.v1 = *(const v4u*)(zr + ZB_V + tl * 256 + 32 * w + 16);
    x.g0 = *(const v4u*)(zr + ZB_G + tl * 256 + 32 * w); x.g1 = *(const v4u*)(zr + ZB_G + tl * 256 + 32 * w + 16);
}
__device__ __forceinline__ void unpack8(const v4u p, float (&o)[8]) { o[0] = bf_lo(p.x); o[1] = bf_hi(p.x); o[2] = bf_lo(p.y); o[3] = bf_hi(p.y); o[4] = bf_lo(p.z); o[5] = bf_hi(p.z); o[6] = bf_lo(p.w); o[7] = bf_hi(p.w); }
__device__ __forceinline__ void gla_phase(LAS unsigned char* lds, KArgs a, int l, int tid, int b, int h) {
    asm volatile("" : "+v"(tid));
    const int lane = tid & 63, w = __builtin_amdgcn_readfirstlane(tid >> 6), q = lane >> 4, r16 = lane & 15;
    LAS bf16* QD = (LAS bf16*)(lds + GL_QD); LAS bf16* KI = (LAS bf16*)(lds + GL_KI); LAS bf16* KET = (LAS bf16*)(lds + GL_KET); LAS bf16* VT = (LAS bf16*)(lds + GL_VT); LAS bf16* P = (LAS bf16*)(lds + GL_P);
    LAS float* DEC = (LAS float*)(lds + GL_DEC); LAS float* PS = (LAS float*)(lds + GL_PS); LAS float* OW = (LAS float*)(lds + GL_OW) + w * (64 * GL_OWP);
    const bf16* zb = (const bf16*)(a->ws + WS_HID); bf16* amix = (bf16*)(a->ws + WS_HID);
    float bg[8];
#pragma unroll
    for (int e = 0; e < 8; ++e) bg[e] = a->in[I_BGATE][l * 256 + 64 * h + 8 * w + e];
    f32x4 Sacc[4];
#pragma unroll
    for (int T = 0; T < 4; ++T) Sacc[T] = (f32x4){0.f, 0.f, 0.f, 0.f};
    GlaIn cur, nxt;
    gla_load(cur, zb, (size_t)b * SEQ + lane, h, w);
    float ov[16]; v4u pg0 = (v4u){0u, 0u, 0u, 0u}, pg1 = pg0;
#pragma unroll
    for (int e = 0; e < 16; ++e) ov[e] = 0.f;
#define GLA_OUT(ntok) do {     \
            float ss_ = 0.f; _Pragma("unroll") for (int ww = 0; ww < 8; ++ww) ss_ += PS[ww * 64 + lane]; \
            const float sc_ = rsqrtf(ss_ * (1.0f / 128.0f) + EPS); \
            float g_[16]; { float t8[8]; unpack8(pg0, t8); _Pragma("unroll") for (int e = 0; e < 8; ++e) g_[e] = t8[e]; unpack8(pg1, t8); _Pragma("unroll") for (int e = 0; e < 8; ++e) g_[8 + e] = t8[e]; } \
            float y_[16]; _Pragma("unroll") for (int e = 0; e < 16; ++e) y_[e] = g_[e] * ov[e] * sc_;     \
            bf16* op_ = (bf16*)((char*)amix + amix_addr((ntok), (unsigned)(512 + 128 * h + 16 * w))); \
            *(v4u*)op_ = (v4u){pk2(y_[0], y_[1]), pk2(y_[2], y_[3]), pk2(y_[4], y_[5]), pk2(y_[6], y_[7])}; \
            *(v4u*)(op_ + 8) = (v4u){pk2(y_[8], y_[9]), pk2(y_[10], y_[11]), pk2(y_[12], y_[13]), pk2(y_[14], y_[15])}; } while (0)
    for (int n = 0; n < 32; ++n) {
        const size_t token = (size_t)b * SEQ + n * 64 + lane;
        GLA_OUT(n > 0 ? token - 64 : token);
        gla_load(nxt, zb, (size_t)b * SEQ + (n + 1 < 32 ? n + 1 : 31) * 64 + lane, h, w);
        {
            float gx[8], qv[8], kv[8], cum[8];
            unpack8(cur.gt, gx); unpack8(cur.q, qv); unpack8(cur.k, kv);
#pragma unroll
            for (int e = 0; e < 8; ++e) { const float x = gx[e] + bg[e]; const float ex = __builtin_amdgcn_exp2f(-1.4426950409f * fabsf(x));
                const float ls2 = fmaf(fminf(x, 0.f), 1.4426950409f * (1.0f / 16.0f), (-1.0f / 16.0f) * __builtin_amdgcn_logf(1.0f + ex)); cum[e] = wave_incl_scan(ls2); }
            float qd[8], ki[8], ke[8];
#pragma unroll
            for (int e = 0; e < 8; ++e) { const float X = __builtin_amdgcn_exp2f(cum[e]);
                const float Xtot = __builtin_bit_cast(float, __builtin_amdgcn_readlane(__builtin_bit_cast(int, X), 63));
                qd[e] = qv[e] * 0.125f * X; ki[e] = kv[e] * __builtin_amdgcn_exp2f(-cum[e]); ke[e] = ki[e] * Xtot;
                if (lane == 63) DEC[8 * w + e] = X; }
            *(LAS v4u*)(QD + lane * GP + 8 * w) = (v4u){pk2(qd[0], qd[1]), pk2(qd[2], qd[3]), pk2(qd[4], qd[5]), pk2(qd[6], qd[7])};
            *(LAS v4u*)(KI + lane * GP + 8 * w) = (v4u){pk2(ki[0], ki[1]), pk2(ki[2], ki[3]), pk2(ki[4], ki[5]), pk2(ki[6], ki[7])};
#pragma unroll
            for (int e = 0; e < 8; ++e) KET[(8 * w + e) * GP + lane] = (bf16)f2bf(ke[e]);
            const unsigned vw[8] = {cur.v0.x, cur.v0.y, cur.v0.z, cur.v0.w, cur.v1.x, cur.v1.y, cur.v1.z, cur.v1.w};
#pragma unroll
            for (int e = 0; e < 8; ++e) { VT[(16 * w + 2 * e) * GP + lane] = (bf16)(vw[e] & 0xffffu); VT[(16 * w + 2 * e + 1) * GP + lane] = (bf16)(vw[e] >> 16); }
        }
        __syncthreads();
        {
            const int ti = w >> 1;
            bf16x8 af[2][2], bf[2];
#pragma unroll
            for (int kk = 0; kk < 2; ++kk) { bf[kk] = *(const LAS bf16x8*)(QD + (16 * ti + r16) * GP + 32 * kk + 8 * q);
#pragma unroll
                for (int s2 = 0; s2 < 2; ++s2) af[s2][kk] = *(const LAS bf16x8*)(KI + (16 * (2 * (w & 1) + s2) + r16) * GP + 32 * kk + 8 * q); }
            __builtin_amdgcn_sched_barrier(0);
#pragma unroll
            for (int s2 = 0; s2 < 2; ++s2) { const int si = 2 * (w & 1) + s2; f32x4 acc = (f32x4){0.f, 0.f, 0.f, 0.f};
#pragma unroll
                for (int kk = 0; kk < 2; ++kk) acc = __builtin_amdgcn_mfma_f32_16x16x32_bf16(af[s2][kk], bf[kk], acc, 0, 0, 0);
                const int t = 16 * ti + r16, s0 = 16 * si + 4 * q;
                const float p0 = (s0 + 0 <= t) ? acc[0] : 0.f, p1 = (s0 + 1 <= t) ? acc[1] : 0.f, p2 = (s0 + 2 <= t) ? acc[2] : 0.f, p3 = (s0 + 3 <= t) ? acc[3] : 0.f;
                *(LAS v2u*)(P + t * GP + s0) = (v2u){pk2(p0, p1), pk2(p2, p3)}; }
        }
        __syncthreads();
        {
            f32x4 o[4];
            bf16x8 pf[4][2], vf[2], kf[4][2]; v2u qlo[4][2], qhi[4][2]; f32x4 d4[4];
#pragma unroll
            for (int kk = 0; kk < 2; ++kk) { vf[kk] = *(const LAS bf16x8*)(VT + (16 * w + r16) * GP + 32 * kk + 8 * q);
#pragma unroll
                for (int i = 0; i < 4; ++i) { pf[i][kk] = *(const LAS bf16x8*)(P + (16 * i + r16) * GP + 32 * kk + 8 * q);
                    qlo[i][kk] = *(const LAS v2u*)(QD + (16 * i + r16) * GP + 32 * kk + 4 * q); qhi[i][kk] = *(const LAS v2u*)(QD + (16 * i + r16) * GP + 32 * kk + 16 + 4 * q); } }
            __builtin_amdgcn_sched_barrier(0);
#pragma unroll
            for (int i = 0; i < 4; ++i) { o[i] = (f32x4){0.f, 0.f, 0.f, 0.f};
#pragma unroll
                for (int kk = 0; kk < 2; ++kk) if (32 * kk <= 16 * i + 15) o[i] = __builtin_amdgcn_mfma_f32_16x16x32_bf16(pf[i][kk], vf[kk], o[i], 0, 0, 0); }
#pragma unroll
            for (int T = 0; T < 4; ++T) { d4[T] = *(const LAS f32x4*)(DEC + 16 * T + 4 * q);
#pragma unroll
                for (int kk = 0; kk < 2; ++kk) kf[T][kk] = *(const LAS bf16x8*)(KET + (16 * T + r16) * GP + 32 * kk + 8 * q); }
#pragma unroll
            for (int kk = 0; kk < 2; ++kk) { const f32x4 s0 = Sacc[2 * kk], s1 = Sacc[2 * kk + 1]; v4u bw; bw.x = pk2(s0[0], s0[1]); bw.y = pk2(s0[2], s0[3]); bw.z = pk2(s1[0], s1[1]); bw.w = pk2(s1[2], s1[3]);
                const bf16x8 bfS = __builtin_bit_cast(bf16x8, bw);
#pragma unroll
                for (int i = 0; i < 4; ++i) { const bf16x8 af = __builtin_bit_cast(bf16x8, ((v4u){qlo[i][kk].x, qlo[i][kk].y, qhi[i][kk].x, qhi[i][kk].y}));
                    o[i] = __builtin_amdgcn_mfma_f32_16x16x32_bf16(af, bfS, o[i], 0, 0, 0); } }
#pragma unroll
            for (int i = 0; i < 4; ++i)
#pragma unroll
                for (int r = 0; r < 4; ++r) OW[(16 * i + 4 * q + r) * GL_OWP + r16] = o[i][r];
#pragma unroll
            for (int T = 0; T < 4; ++T) { Sacc[T] = Sacc[T] * d4[T];
#pragma unroll
                for (int kk = 0; kk < 2; ++kk) Sacc[T] = __builtin_amdgcn_mfma_f32_16x16x32_bf16(kf[T][kk], vf[kk], Sacc[T], 0, 0, 0); }
            float ss = 0.f;
#pragma unroll
            for (int c = 0; c < 4; ++c) { const f32x4 t4 = *(const LAS f32x4*)(OW + lane * GL_OWP + 4 * c); ov[4 * c] = t4[0]; ov[4 * c + 1] = t4[1]; ov[4 * c + 2] = t4[2]; ov[4 * c + 3] = t4[3];
                ss += (t4[0] * t4[0] + t4[1] * t4[1]) + (t4[2] * t4[2] + t4[3] * t4[3]); }
            PS[w * 64 + lane] = ss;
        }
        __syncthreads();
        pg0 = cur.g0; pg1 = cur.g1;
        cur = nxt;
    }
    GLA_OUT((size_t)b * SEQ + 31 * 64 + lane);
#undef GLA_OUT
    __syncthreads();
}

__device__ __forceinline__ void final_norm(KArgs a, int lane, int wave) {
    asm volatile("" : "+v"(lane));
    const u64* rs = (const u64*)(a->ws + WS_RS) + (size_t)8 * M; const int rbase = (blockIdx.x & 7) * 8192 + (blockIdx.x >> 3) * 256;
    f32x4 gn[4];
#pragma unroll
    for (int j = 0; j < 4; ++j) gn[j] = ((const f32x4*)a->in[I_NORM_FINAL])[64 * j + lane];
    for (int m = rbase + wave; m < rbase + 256; m += 4 * NWAVES) {
        v2u w[4][4]; float r[4];
#pragma unroll
        for (int q = 0; q < 4; ++q) { const GAS char* xbp = (const GAS char*)(a->ws + WS_XB); r[q] = rs_get(rs, m + q * NWAVES);
#pragma unroll
            for (int j = 0; j < 4; ++j) w[q][j] = *(const GAS v2u*)(xbp + xb_off((unsigned)(m + q * NWAVES), (unsigned)(4 * lane + 256 * j))); }
#pragma unroll
        for (int q = 0; q < 4; ++q) { GAS f32x4* orow = (GAS f32x4*)(a->out + (size_t)(m + q * NWAVES) * D) + lane; const float rr = rsqrtf(r[q] * (1.0f / D) + EPS);
#pragma unroll
            for (int j = 0; j < 4; ++j) { const f32x4 v = (f32x4){bf_lo(w[q][j].x), bf_hi(w[q][j].x), bf_lo(w[q][j].y), bf_hi(w[q][j].y)}; orow[64 * j] = v * rr * gn[j]; } } }
}

constexpr int PH_PER_LAYER = 6;
constexpr int N_PHASES = 2 + PH_PER_LAYER * DEPTH;

__global__ void __launch_bounds__(NWAVES * 64, 2) hymba_fwd(Args args) {
    extern __shared__ __attribute__((aligned(16))) unsigned char lds_raw[];
    LAS unsigned char* lds = (LAS unsigned char*)lds_raw;
    const int tid = threadIdx.x, lane = tid & 63, wave = __builtin_amdgcn_readfirstlane(tid >> 6);
    const int G = gridDim.x;
    volatile LAS unsigned* MISC = (volatile LAS unsigned*)(lds + MISC_OFF);
    for (int u = tid; u < (LDS_BYTES - LDSCTL_OFF) / 4; u += NWAVES * 64) ((LAS unsigned*)(lds + LDSCTL_OFF))[u] = 0u;
    __syncthreads();
    const int lo = args.ph_lo, hi = args.ph_hi;
    const int gx = blockIdx.x & 7, gj = blockIdx.x >> 3;
    unsigned* barw = (unsigned*)(args.ws + WS_CTL) + CW_BAR;
    const XcdBarrier bar = xcd_barrier_post(barw, MISC + 8, (unsigned)G);
    const XcdBarrier gbar = xcd_barrier_post(barw + (1 + gx) * XCD_BAR_WORDS, MISC + 12, (unsigned)(G / 8));
    XcdBarrier sbar = gbar;
    if (gj >= 16) sbar = xcd_barrier_post(barw + (9 + gx) * XCD_BAR_WORDS, MISC + 16, (unsigned)(G / 16));
    const XcdBarrier cbar = xcd_barrier_post(barw + (17 + gx * 8 + (gj & 7)) * XCD_BAR_WORDS, MISC + 20, 4u);
#ifndef PHM
#define PHM 0xFFFFu
#endif
#define IN(k) (lo <= (k) && (k) < hi)
#define HAS(j) ((PHM >> (j)) & 1u)
#ifndef PROBE_REP
#define PROBE_REP 0u
#endif
#define REP(j) for (int rep_ = 0, nrep_ = 1 + (int)((PROBE_REP >> (j)) & 1u); rep_ < nrep_; ++rep_)
#define ZM ((rep_ == nrep_ - 1) ? 1.0f : 0.0f)
#define SEAM(k) do { if (IN(k) && IN((k) + 1)) xcd_barrier(bar); } while (0)
#define SEAMG(k) do { if (IN(k) && IN((k) + 1)) xcd_barrier(gbar); } while (0)
#define SEAMC(k) do { if (IN(k) && IN((k) + 1)) xcd_barrier(cbar); } while (0)
#define SITE() KArgs ka = kargs(); unsigned char* ws = ka->ws; u64* rsq = (u64*)(ws + WS_RS); (void)rsq

    if (HAS(0) && IN(0)) REP(0) { p0_prologue(lds, kargs(), tid, lane, wave); }
    SEAM(0);

    for (int l = 0; l < DEPTH; ++l) {
        const int pb = 1 + PH_PER_LAYER * l;
        if (HAS(1) && IN(pb + 0)) REP(1) {
            SITE();
            pg8::Gemm g{(const bf16*)(ws + WS_XB), (const bf16*)(ws + WS_W1) + (size_t)l * NIN * D, M, NIN, D, 64, D, 30, 0, 30, 0, (size_t)32768, (size_t)524288};
            pg8::StaticOrder S; S.init(M, NIN, G, (int)blockIdx.x);
            EpiIn E{rsq + (size_t)(2 * l) * M, (bf16*)(ws + WS_AEXT), (bf16*)(ws + WS_HID)};
            pg8::gemm_phase<EpiIn, pg8::StaticOrder>(lds + RING_OFF, g, S, E);
        }
        SEAMG(pb + 0);
        if (HAS(2) && IN(pb + 1)) REP(2) {
            if (gj < 16) { gla_phase(lds + RING_OFF, kargs(), l, tid, 4 * gx + (gj >> 2), gj & 3); }
            else {
                for (int i = 0; i < 4; ++i) {
                    const int idx = (gj - 16) * 4 + i; const OneUnit S{(idx >> 1) * 16 + 2 * gx + (idx & 1)};
                    {
                        SITE();
                        pg8::Gemm g{(const bf16*)(ws + WS_AEXT), (const bf16*)(ws + WS_WX) + (size_t)l * 32 * 256 * 256, 32 * 4096, 256, 256, AEXT_LD, 256, 4, (size_t)256 * 256 * 2, 30, 0, 0, 0};
                        EpiXS E{(const float2*)(ws + WS_AT) + (size_t)l * 32 * 64, (bf16*)(ws + WS_AEXT)};
                        pg8::gemm_phase<EpiXS, OneUnit>(lds + RING_OFF, g, S, E);
                    }
                }
                {
                    SITE();
                    pg8::Gemm g{(const bf16*)(ws + WS_AEXT), (const bf16*)(ws + WS_WY) + (size_t)l * 32 * 256 * 384, 32 * 4096, 256, 384, AEXT_LD, 384, 4, (size_t)256 * 384 * 2, 30, 0, 0, 0};
                    EpiY E{(bf16*)(ws + WS_YG)}; const FourUnits S4{(gj - 16) * 4, gx};
                    pg8::gemm_phase<EpiY, FourUnits>(lds + RING_OFF, g, S4, E);
                }
                xcd_barrier(sbar);
                {
                    SITE();
                    pg8::Gemm g{(const bf16*)(ws + WS_YG), (const bf16*)(ws + WS_WG) + (size_t)l * 512 * 512, M, 512, 512, 64, 512, 30, 0, 30, 0, (size_t)32768, (size_t)262144};
                    pg8::StaticOrder S; S.init(M, 512, G / 2, gx + 8 * (gj - 16));
                    EpiGlu E{(const bf16*)(ws + WS_YG), ka->in[I_BGLU] + l * 512, (bf16*)(ws + WS_HID), rsq + (size_t)(9 + l) * M, ZM};
                    pg8::gemm_phase<EpiGlu, pg8::StaticOrder>(lds + RING_OFF, g, S, E);
                }
            }
        }
        SEAMG(pb + 1);
        if (HAS(4) && IN(pb + 3)) REP(4) {
            SITE();
            pg8::Gemm g{(const bf16*)(ws + WS_HID + PANEL_AMIX), (const bf16*)(ws + WS_WO) + (size_t)l * D * D, M, D, D, 64, D, 30, 0, 30, 0, (size_t)32768, PANEL};
            pg8::StaticOrder S; S.init(M, D, G, (int)blockIdx.x);
            EpiRes<true> E{(bf16*)(ws + WS_XB), rsq + (size_t)(9 + l) * M, rsq + (size_t)(2 * l + 1) * M, ZM};
            pg8::gemm_phase<EpiRes<true>, pg8::StaticOrder>(lds + RING_OFF, g, S, E);
        }
        SEAMC(pb + 3);
        if (HAS(5) && IN(pb + 4)) REP(5) {
            SITE();
            pg8::Gemm g{(const bf16*)(ws + WS_XB), (const bf16*)(ws + WS_WF1) + (size_t)l * NFF2 * D, M, NFF2, D, 64, D, 30, 0, 30, 0, (size_t)32768, (size_t)524288};
            pg8::StaticOrder S; S.init(M, NFF2, G, (int)blockIdx.x);
            EpiFfn E{rsq + (size_t)(2 * l + 1) * M, (bf16*)(ws + WS_HID), {}, -1};
            pg8::gemm_phase<EpiFfn, pg8::StaticOrder>(lds + RING_OFF, g, S, E);
        }
        SEAMC(pb + 4);
        if (HAS(6) && IN(pb + 5)) REP(6) {
            SITE();
            pg8::Gemm g{(const bf16*)(ws + WS_HID), (const bf16*)(ws + WS_WF2) + (size_t)l * D * DFF, M, D, DFF, 64, DFF, 30, 0, 30, 0, (size_t)256 * 128, (size_t)256 * DFF * 2};
            pg8::StaticOrder S; S.init(M, D, G, (int)blockIdx.x);
            EpiRes<false> E{(bf16*)(ws + WS_XB), nullptr, rsq + (size_t)(2 * l + 2) * M, ZM};
            pg8::gemm_phase<EpiRes<false>, pg8::StaticOrder>(lds + RING_OFF, g, S, E);
        }
        SEAMC(pb + 5);
    }
    if (HAS(7) && IN(N_PHASES - 1)) { final_norm(kargs(), lane, wave); }
#undef IN
#undef SEAM
}

extern "C" void kernel_launch(void* const* d_in, const int* in_sizes, int n_in, void* d_out, int out_size, void* d_ws, size_t ws_size, hipStream_t stream) {
    static int grid = 0;
    if (grid == 0) {
        if (n_in != 22 || in_sizes[0] != M * D || out_size != M * D || ws_size < WS_END) { fprintf(stderr, "kernel_launch: unexpected shapes (n_in %d, in0 %d, out %d, ws %zu < %zu); nothing launched\n", n_in, n_in > 0 ? in_sizes[0] : -1, out_size, ws_size, (size_t)WS_END); grid = -1; return; }
        int dev = 0, cus = 0, per_cu = 0;
        if (hipGetDevice(&dev) != hipSuccess || hipDeviceGetAttribute(&cus, hipDeviceAttributeMultiprocessorCount, dev) != hipSuccess) { grid = -1; return; }
        if (hipFuncSetAttribute((const void*)hymba_fwd, hipFuncAttributeMaxDynamicSharedMemorySize, LDS_BYTES) != hipSuccess) { fprintf(stderr, "kernel_launch: hipFuncSetAttribute failed\n"); grid = -1; return; }
        if (hipOccupancyMaxActiveBlocksPerMultiprocessor(&per_cu, (const void*)hymba_fwd, NWAVES * 64, LDS_BYTES) != hipSuccess || per_cu < 1)
            fprintf(stderr, "kernel_launch: note: occupancy query reports %d workgroups per CU\n", per_cu);
        (void)hipGetLastError();
        grid = cus;
        if (grid != 256) { fprintf(stderr, "kernel_launch: this kernel's label-group schedule is built for 256 CUs (got %d); nothing launched\n", grid); grid = -1; return; }
    }
    if (grid < 0) return;
    if (hipMemsetAsync((char*)d_ws + WS_CTL, 0, CTL_ZERO_BYTES, stream) != hipSuccess) return;
    Args a{};
    for (int i = 0; i < 22; ++i) a.in[i] = (const float*)d_in[i];
    a.out = (float*)d_out; a.ws = (unsigned char*)d_ws;
    a.ph_lo = 0; a.ph_hi = N_PHASES;
    hipLaunchKernelGGL(hymba_fwd, dim3(grid), dim3(NWAVES * 64), LDS_BYTES, stream, a);
}
```

```cpp
#include <hip/hip_runtime.h>
#include <cstdio>
#include <cstdint>


namespace pg8 {
#define PG8_LAS __attribute__((address_space(3)))
typedef unsigned short bf16_t;
typedef short bf16x8 __attribute__((ext_vector_type(8)));
typedef float f32x4 __attribute__((ext_vector_type(4)));
typedef unsigned u32x4 __attribute__((ext_vector_type(4)));
typedef unsigned u32x2 __attribute__((ext_vector_type(2)));
constexpr int BM = 256, BK = 64, HALF = 128, HTB = HALF * BK * 2, STAGE_BYTES = 8 * HTB, NXCD = 8, WGM = 8;

__host__ __device__ __forceinline__ int lds_byte(int r, int c) { const int st = (r >> 4) * 2 + (c >> 5), rr = r & 15, cc = c & 31, ob = rr * 64 + cc * 2; return st * 1024 + (ob ^ (((ob >> 9) & 1) << 5)); }
__host__ __device__ __forceinline__ void stage_rc(int b, int& R, int& C) { const int st = b / 1024, sb = b % 1024, swz = sb ^ (((sb >> 9) & 1) << 5); R = (st >> 1) * 16 + swz / 64; C = (st & 1) * 32 + (swz % 64) / 2; }
__host__ __device__ __forceinline__ int perm32(int rho) { const int n = rho >> 4, i = rho & 15; return 8 * (i >> 2) + 4 * n + (i & 3); }

struct Unit { int pm, pn; };
struct Gemm { const bf16_t* A; const bf16_t* Bt; int M, N, K, lda, ldb, gshift; size_t gstrideB; int ashift; size_t astrideA; size_t kstepA, tstepA; };

struct StaticOrder {
    int nM, nN, nwg, G, c;
    __host__ __device__ void init(int M, int N, int G_, int c_) { nM = M / BM; nN = N / BM; nwg = nM * nN; G = G_; c = c_; }
    __host__ __device__ bool next(int i, Unit& u) const {
        const long L = (long)i * G + c; if (L >= nwg) return false;
        int wgid = (int)L; { const int q = nwg / NXCD, r = nwg % NXCD, xcd = wgid % NXCD, off = wgid / NXCD; wgid = (xcd < r ? xcd * (q + 1) : r * (q + 1) + (xcd - r) * q) + off; }
        const int nig = WGM * nN, gid = wgid / nig, fm = gid * WGM, gsz = (nM - fm) < WGM ? (nM - fm) : WGM;
        u.pm = fm + ((wgid % nig) % gsz); u.pn = (wgid % nig) / gsz; return true;
    }
    __device__ __forceinline__ void a_ready(const Unit&) const {}
    __device__ __forceinline__ void done(const Unit&) const {}
};

__device__ __forceinline__ unsigned cvt_pk_bf16(float lo, float hi) { unsigned r; asm volatile("v_cvt_pk_bf16_f32 %0, %1, %2" : "=v"(r) : "v"(lo), "v"(hi)); return r; }

template <class Epi, class Sched, bool ALIGN_EPI = true, bool SP2 = true>
__device__ __forceinline__ void gemm_phase(PG8_LAS unsigned char* lds, const Gemm g, const Sched& S, const Epi& E) {
    int tid_ = threadIdx.x; asm volatile("" : "+v"(tid_));
    const int tid = tid_, wid = __builtin_amdgcn_readfirstlane(tid >> 6), lane = tid & 63, wr = wid >> 2, wc = wid & 3, fr = lane & 15, fq = lane >> 4;
    const int K = g.K, nt = K / BK;
    unsigned voffA[2], voffB[2];
#pragma unroll
    for (int i = 0; i < 2; ++i) { int R, C; stage_rc(tid * 16 + i * 8192, R, C); const int Rb = Epi::PERM ? ((R & ~31) + perm32(R & 31)) : R;
        voffA[i] = (unsigned)(R * g.lda + C) * 2u; voffB[i] = (unsigned)(Rb * g.ldb + C) * 2u; }
    const size_t kstep = (size_t)(BK * 2), kstepA = g.kstepA ? g.kstepA : kstep;
    const size_t hstepA = (size_t)HALF * g.lda * 2, hstepB = (size_t)HALF * g.ldb * 2;
    const size_t tstepA = g.tstepA ? g.tstepA : 2 * hstepA, tstepB = 2 * hstepB;
    const unsigned ldsw = (unsigned)wid * 1024u;
    const int aoff = lds_byte(wr * 64 + fr, fq * 8), boff = lds_byte(wc * 32 + fr, fq * 8);
#define PG8_SA(b, h) (((b) * 2 + (h)) * HTB)
#define PG8_SB(b, h) ((4 + (b) * 2 + (h)) * HTB)
#define PG8_STAGE(bufoff, gbase, voff) do { _Pragma("unroll") for (int _i = 0; _i < 2; ++_i) \
        __builtin_amdgcn_global_load_lds((const unsigned*)((const char*)(gbase) + (voff)[_i]), (PG8_LAS unsigned*)(lds + (bufoff) + ldsw + _i * 8192), 16, 0, 0); } while (0)
#define PG8_LDA(dst, b, h) do { _Pragma("unroll") for (int m = 0; m < 4; ++m) _Pragma("unroll") for (int k = 0; k < 2; ++k) dst[m][k] = *(const PG8_LAS bf16x8*)(lds + PG8_SA(b, h) + aoff + m * 2048 + k * 1024); } while (0)
#define PG8_LDB(dst, b, h) do { _Pragma("unroll") for (int n = 0; n < 2; ++n) _Pragma("unroll") for (int k = 0; k < 2; ++k) dst[n][k] = *(const PG8_LAS bf16x8*)(lds + PG8_SB(b, h) + boff + n * 2048 + k * 1024); } while (0)
#define PG8_MMA(ai, bj, At, Bt) do { __builtin_amdgcn_s_setprio(1); _Pragma("unroll") for (int m = 0; m < 4; ++m) _Pragma("unroll") for (int n = 0; n < 2; ++n) _Pragma("unroll") for (int k = 0; k < 2; ++k) \
        acc[ai][bj][m][n] = __builtin_amdgcn_mfma_f32_16x16x32_bf16(Bt[n][k], At[m][k], acc[ai][bj][m][n], 0, 0, 0); __builtin_amdgcn_s_setprio(0); } while (0)
#define PG8_WAIT_V(n) asm volatile("s_waitcnt vmcnt(" #n ")" ::: "memory")
#define PG8_WAIT_L(n) asm volatile("s_waitcnt lgkmcnt(" #n ")" ::: "memory")
#define PG8_BAR __builtin_amdgcn_s_barrier()
#define PG8_SCHED __builtin_amdgcn_sched_barrier(0)
    Unit cur, nxt; int ui = 0;
    if (!S.next(0, cur)) return;
    f32x4 acc[2][2][4][2];
#pragma unroll
    for (int a = 0; a < 2; ++a)
#pragma unroll
        for (int b = 0; b < 2; ++b)
#pragma unroll
            for (int m = 0; m < 4; ++m)
#pragma unroll
                for (int n = 0; n < 2; ++n) acc[a][b][m][n] = (f32x4){0.f, 0.f, 0.f, 0.f};
    bf16x8 At[4][2], B0[2][2], B1[2][2];
    const int amask = (1 << g.ashift) - 1;
    const char* cA = (const char*)g.A + (size_t)(cur.pm >> g.ashift) * g.astrideA + (size_t)(cur.pm & amask) * tstepA; const char* cB = (const char*)g.Bt + (size_t)(cur.pm >> g.gshift) * g.gstrideB + (size_t)cur.pn * tstepB;
    S.a_ready(cur);
    if constexpr (SP2) {
        PG8_STAGE(PG8_SB(0, 0), cB, voffB); PG8_STAGE(PG8_SB(0, 1), cB + hstepB, voffB); PG8_STAGE(PG8_SA(0, 0), cA, voffA); PG8_STAGE(PG8_SA(0, 1), cA + hstepA, voffA);
        if (wr == 1) PG8_BAR;
        PG8_WAIT_V(2); PG8_BAR;
        PG8_STAGE(PG8_SB(1, 0), cB + kstep, voffB); PG8_STAGE(PG8_SA(1, 0), cA + kstepA, voffA); PG8_STAGE(PG8_SB(1, 1), cB + hstepB + kstep, voffB);
        PG8_WAIT_V(6); PG8_BAR;
    } else {
        PG8_STAGE(PG8_SB(0, 0), cB, voffB); PG8_STAGE(PG8_SA(0, 0), cA, voffA); PG8_STAGE(PG8_SB(0, 1), cB + hstepB, voffB); PG8_STAGE(PG8_SA(0, 1), cA + hstepA, voffA);
        if (wr == 1) PG8_BAR;
        PG8_WAIT_V(4); PG8_BAR;
        PG8_STAGE(PG8_SB(1, 0), cB + kstep, voffB); PG8_STAGE(PG8_SA(1, 0), cA + kstepA, voffA); PG8_STAGE(PG8_SB(1, 1), cB + hstepB + kstep, voffB);
        PG8_WAIT_V(6); PG8_BAR;
    }
    for (;;) {
        const bool has_next = S.next(ui + 1, nxt);
        const char* nA = has_next ? (const char*)g.A + (size_t)(nxt.pm >> g.ashift) * g.astrideA + (size_t)(nxt.pm & amask) * tstepA : cA;
        const char* nB = has_next ? (const char*)g.Bt + (size_t)(nxt.pm >> g.gshift) * g.gstrideB + (size_t)nxt.pn * tstepB : cB;
#pragma nounroll
        for (int t = 0; t < nt; t += 2) {
            const bool last = (t == nt - 2);
            const char* a1 = cA + (size_t)(t + 1) * kstepA;
            const char* a2 = last ? nA : cA + (size_t)(t + 2) * kstepA; const char* b2 = last ? nB : cB + (size_t)(t + 2) * kstep;
            const char* a3 = a2 + kstepA; const char* b3 = b2 + kstep;
            if (last && has_next) S.a_ready(nxt);
            if constexpr (SP2) {
            PG8_LDB(B0, 0, 0); PG8_LDB(B1, 0, 1); PG8_SCHED; PG8_LDA(At, 0, 0); PG8_STAGE(PG8_SA(1, 1), a1 + hstepA, voffA);
            PG8_WAIT_V(8); PG8_WAIT_L(0); PG8_BAR; PG8_MMA(0, 0, At, B0); PG8_MMA(0, 1, At, B1); PG8_BAR; PG8_SCHED;
            PG8_LDA(At, 0, 1); PG8_STAGE(PG8_SB(0, 0), b2, voffB); PG8_STAGE(PG8_SB(0, 1), b2 + hstepB, voffB); PG8_STAGE(PG8_SA(0, 0), a2, voffA);
            PG8_WAIT_V(8); PG8_WAIT_L(0); PG8_BAR; PG8_MMA(1, 0, At, B0); PG8_MMA(1, 1, At, B1); PG8_BAR; PG8_SCHED;
            PG8_LDB(B0, 1, 0); PG8_LDB(B1, 1, 1); PG8_SCHED; PG8_LDA(At, 1, 0); PG8_STAGE(PG8_SA(0, 1), a2 + hstepA, voffA);
            PG8_WAIT_V(8); PG8_WAIT_L(0); PG8_BAR; PG8_MMA(0, 0, At, B0); PG8_MMA(0, 1, At, B1); PG8_BAR; PG8_SCHED;
            PG8_LDA(At, 1, 1); PG8_STAGE(PG8_SB(1, 0), b3, voffB); PG8_STAGE(PG8_SB(1, 1), b3 + hstepB, voffB); PG8_STAGE(PG8_SA(1, 0), a3, voffA);
            PG8_WAIT_V(8); PG8_WAIT_L(0); PG8_BAR; PG8_MMA(1, 0, At, B0); PG8_MMA(1, 1, At, B1); PG8_BAR; PG8_SCHED;
            if constexpr (Epi::KSCALE_T >= 0) { if (t == Epi::KSCALE_T) E.kscale(acc, cur, wr, fr); }
            } else {
            PG8_LDB(B0, 0, 0); PG8_SCHED; PG8_LDA(At, 0, 0); PG8_STAGE(PG8_SA(1, 1), a1 + hstepA, voffA);
            PG8_WAIT_L(8); PG8_BAR; PG8_WAIT_L(0); PG8_MMA(0, 0, At, B0); PG8_BAR; PG8_SCHED;
            PG8_LDB(B1, 0, 1); PG8_STAGE(PG8_SB(0, 0), b2, voffB);
            PG8_BAR; PG8_WAIT_L(0); PG8_MMA(0, 1, At, B1); PG8_BAR;
            PG8_LDA(At, 0, 1); PG8_STAGE(PG8_SA(0, 0), a2, voffA);
            PG8_BAR; PG8_WAIT_L(0); PG8_MMA(1, 0, At, B0); PG8_BAR; PG8_SCHED;
            PG8_STAGE(PG8_SB(0, 1), b2 + hstepB, voffB);
            PG8_WAIT_V(6); PG8_BAR; PG8_MMA(1, 1, At, B1); PG8_BAR;
            PG8_LDB(B0, 1, 0); PG8_SCHED; PG8_LDA(At, 1, 0); PG8_STAGE(PG8_SA(0, 1), a2 + hstepA, voffA);
            PG8_WAIT_L(8); PG8_BAR; PG8_WAIT_L(0); PG8_MMA(0, 0, At, B0); PG8_BAR; PG8_SCHED;
            PG8_LDB(B1, 1, 1); PG8_STAGE(PG8_SB(1, 0), b3, voffB);
            PG8_BAR; PG8_WAIT_L(0); PG8_MMA(0, 1, At, B1); PG8_BAR;
            PG8_LDA(At, 1, 1); PG8_STAGE(PG8_SA(1, 0), a3, voffA);
            PG8_BAR; PG8_WAIT_L(0); PG8_MMA(1, 0, At, B0); PG8_BAR; PG8_SCHED;
            PG8_STAGE(PG8_SB(1, 1), b3 + hstepB, voffB);
            PG8_WAIT_V(6); PG8_BAR; PG8_MMA(1, 1, At, B1); PG8_BAR;
            }
        }
        if constexpr (ALIGN_EPI) { if (wr == 0) PG8_BAR; }
        if constexpr (!Epi::AFTER_DRAIN) E(acc, cur, wr, wc, fr, fq);
        S.done(cur);
        if (!has_next) break;
#pragma unroll
        for (int a = 0; a < 2; ++a)
#pragma unroll
            for (int b = 0; b < 2; ++b)
#pragma unroll
                for (int m = 0; m < 4; ++m)
#pragma unroll
                    for (int n = 0; n < 2; ++n) acc[a][b][m][n] = (f32x4){0.f, 0.f, 0.f, 0.f};
        cur = nxt; cA = nA; cB = nB; ++ui;
        if constexpr (ALIGN_EPI) { if (wr == 1) PG8_BAR; }
    }
    PG8_WAIT_V(0);
    if constexpr (!ALIGN_EPI) { if (wr == 0) PG8_BAR; }
    PG8_BAR;
    if constexpr (Epi::AFTER_DRAIN) E.fused(acc, cur, wr, wc, fr, fq, lds, tid);
#undef PG8_SA
#undef PG8_SB
#undef PG8_STAGE
#undef PG8_LDA
#undef PG8_LDB
#undef PG8_MMA
#undef PG8_WAIT_V
#undef PG8_WAIT_L
#undef PG8_BAR
#undef PG8_SCHED
}
}

constexpr int NWAVES = 8;
constexpr int M = 65536, D = 1024, SEQ = 2048, BATCH = 32, DEPTH = 4;
constexpr int D_IN_SRC = 2064, NIN = 2304, DFF = 2816, NFF2 = 5632;
constexpr int ZBW = 1792;
constexpr int AEXT_LD = 384;
constexpr float EPS = 1e-6f;
constexpr size_t MiB = 1u << 20;
constexpr size_t WS_CTL = 0, CTL_ZERO_BYTES = 2 * MiB;
constexpr size_t WS_RS = 844 * MiB;
constexpr size_t WS_AT = 5 * MiB;
constexpr size_t WS_W1 = 6 * MiB, WS_WG = 24 * MiB, WS_WO = 26 * MiB, WS_WF1 = 34 * MiB, WS_WF2 = 78 * MiB, WS_WX = 100 * MiB, WS_WY = 116 * MiB;
constexpr size_t WS_XB = 140 * MiB;
constexpr size_t WS_HID = 268 * MiB;
constexpr size_t WS_AEXT = 620 * MiB;
constexpr size_t WS_XS = 716 * MiB;
constexpr size_t WS_YG = 780 * MiB;
constexpr size_t WS_END = 852 * MiB;
static_assert(WS_W1 + (size_t)DEPTH * NIN * D * 2 <= WS_WG && WS_WG + (size_t)DEPTH * 512 * 512 * 2 <= WS_WO && WS_WO + (size_t)DEPTH * D * D * 2 <= WS_WF1 &&
              WS_WF1 + (size_t)DEPTH * NFF2 * D * 2 <= WS_WF2 && WS_WF2 + (size_t)DEPTH * D * DFF * 2 <= WS_WX && WS_WX + (size_t)DEPTH * 32 * 256 * 256 * 2 <= WS_WY &&
              WS_WY + (size_t)DEPTH * 32 * 256 * 384 * 2 <= WS_XB && WS_XB + (size_t)M * D * 2 <= WS_HID && WS_HID + (size_t)M * DFF * 2 <= WS_AEXT &&
              WS_AEXT + (size_t)32 * 4096 * AEXT_LD * 2 <= WS_XS &&
              WS_XS + (size_t)32 * 4096 * 128 * 4 <= WS_YG && WS_YG + (size_t)M * 512 * 2 <= WS_RS && WS_RS + 13 * (size_t)M * 8 <= WS_END, "d_ws map");
constexpr size_t PANEL = (size_t)256 * DFF * 2;
constexpr size_t PANEL_AMIX = (size_t)16 * 57344;
constexpr size_t SLAB = 32 * PANEL;
constexpr int ZBLOB = 57344, ZB_GATE = 0, ZB_Q = 8192, ZB_K = 16384, ZB_V = 24576, ZB_G = 40960;
__device__ __forceinline__ size_t zb_blob(size_t row, int h) { const size_t b = row >> 11, n = (row >> 6) & 31; (void)b; return (row >> 8) * PANEL + (((n & 3) * 4 + (size_t)h) * (size_t)ZBLOB); }
__device__ __forceinline__ size_t amix_addr(size_t row, unsigned col) { return (row >> 8) * PANEL + PANEL_AMIX + (size_t)(col >> 6) * 32768 + (row & 255) * 128 + (col & 63) * 2; }
__device__ __forceinline__ unsigned yg_addr(unsigned token, unsigned col) { return (token >> 8) * 262144u + (col >> 6) * 32768u + (token & 255u) * 128u + (col & 63u) * 2u; }
__device__ __forceinline__ unsigned xb_off(unsigned row, unsigned col) { return (row >> 8) * 524288u + (col >> 6) * 32768u + (row & 255u) * 128u + (col & 63u) * 2u; }
constexpr int CW_BAR = 4096;
constexpr int RING_OFF = 0, RING_BYTES = 131072, LDSCTL_OFF = RING_BYTES, MISC_OFF = LDSCTL_OFF + 320, LDS_BYTES = 147456;

#define GAS __attribute__((address_space(1)))
#define LAS __attribute__((address_space(3)))
typedef unsigned short bf16;
typedef unsigned v4u __attribute__((ext_vector_type(4)));
typedef unsigned v2u __attribute__((ext_vector_type(2)));
typedef float f32x4 __attribute__((ext_vector_type(4)));
typedef short bf16x8 __attribute__((ext_vector_type(8)));
typedef short bf16x4 __attribute__((ext_vector_type(4)));
typedef GAS unsigned gu32;
#define RLX_AGENT __ATOMIC_RELAXED, __HIP_MEMORY_SCOPE_AGENT
#define LDS_WAIT() asm volatile("s_waitcnt lgkmcnt(0)" ::: "memory")
__device__ __forceinline__ unsigned f2bf(float f) { unsigned u = __builtin_bit_cast(unsigned, f); return (u + 0x7fffu + ((u >> 16) & 1u)) >> 16; }
__device__ __forceinline__ unsigned pk2(float lo, float hi) { return pg8::cvt_pk_bf16(lo, hi); }
__device__ __forceinline__ float bf_lo(unsigned w) { return __builtin_bit_cast(float, w << 16); }
__device__ __forceinline__ float bf_hi(unsigned w) { return __builtin_bit_cast(float, w & 0xffff0000u); }
__device__ __forceinline__ float bf2f(bf16 b) { return __builtin_bit_cast(float, ((unsigned)b) << 16); }
typedef unsigned long long u64;
__device__ __forceinline__ float rs_get(const u64* p, int row) { return (float)p[row] * (1.0f / 16777216.0f); }
__device__ __forceinline__ float rs_cvt(u64 v) { return (float)v * (1.0f / 16777216.0f); }
__device__ __forceinline__ void rs_get8(const u64* p, int row0, float (&o)[2][4]) {
    u64 raw[2][4];
#pragma unroll
    for (int ai = 0; ai < 2; ++ai)
#pragma unroll
        for (int m = 0; m < 4; ++m) raw[ai][m] = p[row0 + ai * 128 + m * 16];
    asm volatile("" ::: "memory");
#pragma unroll
    for (int ai = 0; ai < 2; ++ai)
#pragma unroll
        for (int m = 0; m < 4; ++m) o[ai][m] = rs_cvt(raw[ai][m]);
}
__device__ __forceinline__ void rs_add(u64* p, int row, float ss) { atomicAdd(p + row, (u64)(ss * 16777216.0f)); }
__device__ __forceinline__ float fsigmoid(float x) { return __builtin_amdgcn_rcpf(1.0f + __builtin_amdgcn_exp2f(-1.4426950409f * x)); }
typedef float f2p __attribute__((ext_vector_type(2)));
__device__ __forceinline__ f2p sigmoid2(f2p x) { const f2p t = x * (f2p){-1.4426950409f, -1.4426950409f}; f2p e; e.x = __builtin_amdgcn_exp2f(t.x); e.y = __builtin_amdgcn_exp2f(t.y);
    const f2p d = e + (f2p){1.0f, 1.0f}; f2p r; r.x = __builtin_amdgcn_rcpf(d.x); r.y = __builtin_amdgcn_rcpf(d.y); return r; }
__device__ __forceinline__ f2p gelu_tanh2(f2p y) { const f2p z = y * (y * y * (f2p){0.044715f, 0.044715f} + (f2p){1.0f, 1.0f}); const f2p t = z * (f2p){-2.3022081995f, -2.3022081995f};
    f2p e; e.x = __builtin_amdgcn_exp2f(t.x); e.y = __builtin_amdgcn_exp2f(t.y); const f2p d = e + (f2p){1.0f, 1.0f}; f2p r; r.x = __builtin_amdgcn_rcpf(d.x); r.y = __builtin_amdgcn_rcpf(d.y); return y * r; }
__device__ __forceinline__ float gelu_tanh(float y) { const float z = y + 0.044715f * y * y * y; return y * __builtin_amdgcn_rcpf(1.0f + __builtin_amdgcn_exp2f(-2.3022081995f * z)); }

#define XB_TMO      128
#define XB_XCNT(j)  (256  + 64 * (j))
#define XB_XSUB(j)  (1280 + 64 * (j))
#define XB_XGEN(j)  (2304 + 64 * (j))
#define XB_TOP      3328
#define XB_TOPGEN   3392
#define XCD_BAR_WORDS 3456
#define XB_SPIN_CAP (1u << 18)
__device__ __forceinline__ unsigned xb_ld(unsigned* p)              { return __hip_atomic_load(p, __ATOMIC_RELAXED, __HIP_MEMORY_SCOPE_AGENT); }
__device__ __forceinline__ unsigned xb_add(unsigned* p, unsigned v) { return __hip_atomic_fetch_add(p, v, __ATOMIC_RELAXED, __HIP_MEMORY_SCOPE_AGENT); }
__device__ __forceinline__ unsigned xb_xcc_id() { return (unsigned)__builtin_amdgcn_s_getreg((3 << 11) | 20) & 0xFu; }
#define XB_SPIN(cond, bar) do { unsigned _sp = 0; while (cond) { __builtin_amdgcn_s_sleep(1); \
    if ((++_sp & 255u) == 0u) { if (xb_ld(&(bar)[XB_TMO])) break; if (_sp > XB_SPIN_CAP) { atomicAdd(&(bar)[XB_TMO], 1u); break; } } } } while (0)
struct XcdBarrier { unsigned* bar; unsigned x; volatile LAS unsigned* st; unsigned G; };
__device__ __forceinline__ XcdBarrier xcd_barrier_post(unsigned* bar, volatile LAS unsigned* st, unsigned G) {
    XcdBarrier b; b.bar = bar; b.x = xb_xcc_id(); b.st = st; b.G = G;
    if (threadIdx.x == 0) (void)xb_add(&bar[XB_XCNT(b.x)], 1u);
    return b;
}
__device__ __forceinline__ void xcd_barrier_complete(unsigned* bar, unsigned x, unsigned& nloc, unsigned& nx, const unsigned G) {
    unsigned sum, cnt, mine, sp = 0u;
    for (;;) {
        sum = 0u; cnt = 0u; mine = 0u;
#pragma unroll
        for (unsigned j = 0; j < 16; ++j) { const unsigned c = xb_ld(&bar[XB_XCNT(j)]); sum += c; cnt += (c > 0u) ? 1u : 0u; mine = (j == x) ? c : mine; }
        if (sum == G) break;
        __builtin_amdgcn_s_sleep(1);
        if ((++sp & 255u) == 0u) { if (xb_ld(&bar[XB_TMO])) break; if (sp > XB_SPIN_CAP) { atomicAdd(&bar[XB_TMO], 1u); break; } }
    }
    nloc = mine > 0u ? mine : 1u; nx = cnt > 0u ? cnt : 1u;
}
__device__ __forceinline__ void xcd_barrier(const XcdBarrier& b) {
    asm volatile("s_waitcnt vmcnt(0)" ::: "memory");
    __syncthreads();
    if (threadIdx.x == 0) {
        unsigned* bar = b.bar;
        __builtin_amdgcn_s_waitcnt(0);
        unsigned nloc = b.st[0], nx = b.st[1];
        if (nloc == 0u) { xcd_barrier_complete(bar, b.x, nloc, nx, b.G); b.st[0] = nloc; b.st[1] = nx; }
        const unsigned old = xb_add(&bar[XB_XSUB(b.x)], 1u);
        const unsigned gen = old / nloc;
        if (old + 1u == (gen + 1u) * nloc) {
            __builtin_amdgcn_fence(__ATOMIC_RELEASE, "agent");
            asm volatile("s_waitcnt vmcnt(0)" ::: "memory");
            const unsigned og = xb_add(&bar[XB_TOP], 1u);
            const unsigned tg = og / nx;
            if (og + 1u == (tg + 1u) * nx) xb_add(&bar[XB_TOPGEN], 1u);
            else XB_SPIN(xb_ld(&bar[XB_TOPGEN]) == tg, bar);
            __builtin_amdgcn_fence(__ATOMIC_ACQUIRE, "agent");
            xb_add(&bar[XB_XGEN(b.x)], 1u);
            asm volatile("s_waitcnt vmcnt(0)" ::: "memory");
        } else {
            XB_SPIN(xb_ld(&bar[XB_XGEN(b.x)]) == gen, bar);
            __builtin_amdgcn_fence(__ATOMIC_ACQUIRE, "agent");
            asm volatile("s_waitcnt vmcnt(0)" ::: "memory");
        }
    }
    __syncthreads();
}

using pg8::Unit;

struct EpiIn { static constexpr int KSCALE_T = -1; static constexpr bool AFTER_DRAIN = false; static constexpr bool PERM = true;
    const u64* rowsq; bf16* aext; bf16* zb;
    __device__ __forceinline__ void store_all(const f32x4 (&acc)[2][2][4][2], const float (&rsv)[2][4], char* base, unsigned c0, unsigned c1, unsigned sa, unsigned sm, int wr) const {
#pragma unroll
        for (int ai = 0; ai < 2; ++ai)
#pragma unroll
            for (int m = 0; m < 4; ++m) { const float rs = rsqrtf(rsv[ai][m] * (1.0f / D) + EPS); const unsigned up = (unsigned)(2 * ai + wr) * sa + (unsigned)m * sm;
#pragma unroll
                for (int bj = 0; bj < 2; ++bj) { const f32x4 v0 = acc[ai][bj][m][0] * rs, v1 = acc[ai][bj][m][1] * rs;
                    v4u w; w.x = pk2(v0[0], v0[1]); w.y = pk2(v0[2], v0[3]); w.z = pk2(v1[0], v1[1]); w.w = pk2(v1[2], v1[3]);
                    *(v4u*)(base + ((bj ? c1 : c0) + up)) = w; }
                asm volatile("" ::: "memory"); }
    }
    __device__ __forceinline__ void operator()(const f32x4 (&acc)[2][2][4][2], const Unit& u, int wr, int wc, int fr, int fq) const {
        const int row0 = u.pm * 256 + wr * 64 + fr, cb = wc * 32 + 8 * fq;
        float rsv[2][4]; rs_get8(rowsq, row0, rsv);
        const int b = u.pm >> 3, p7 = u.pm & 7;
        if (u.pn < 2) {
            const int col0 = u.pn * 256 + cb, col1 = col0 + 128;
            const unsigned c0 = (unsigned)(((col0 >> 4) * 4096 + b * 128 + p7 * 16) * AEXT_LD + fr * 16 + (col0 & 15)) * 2u, c1 = (unsigned)(((col1 >> 4) * 4096 + b * 128 + p7 * 16) * AEXT_LD + fr * 16 + (col1 & 15)) * 2u;
            store_all(acc, rsv, (char*)aext, c0, c1, 4 * AEXT_LD * 2, AEXT_LD * 2, wr);
        } else {
            const bool wide = (u.pn >= 4 && u.pn <= 7); const int pitch = wide ? 256 : 128;
            const int aoff = (u.pn == 2) ? ZB_Q : (u.pn == 3) ? ZB_K : (u.pn < 6) ? ZB_V : (u.pn < 8) ? ZB_G : ZB_GATE;
            unsigned cc[2];
#pragma unroll
            for (int bj = 0; bj < 2; ++bj) { const int ct = bj * 128 + cb, hc = wide ? ((u.pn & 1) * 256 + ct) : ct; const int h = wide ? (hc >> 7) : (hc >> 6), c = wide ? (hc & 127) : (hc & 63);
                cc[bj] = (unsigned)(h * ZBLOB + aoff + (c >> 3) * 1024 + fr * 16); }
            store_all(acc, rsv, (char*)zb + (size_t)u.pm * PANEL, cc[0], cc[1], 4 * ZBLOB, 256, wr);
        }
    }
};
struct TwoUnits { int pm0, pm1, pn;
    __device__ __forceinline__ bool next(int i, Unit& u) const { if (i > 1) return false; u.pm = i ? pm1 : pm0; u.pn = pn; return true; }
    __device__ __forceinline__ void a_ready(const Unit&) const {}
    __device__ __forceinline__ void done(const Unit&) const {}
};
struct OneUnitPN { int pm, pn;
    __device__ __forceinline__ bool next(int i, Unit& u) const { if (i > 0) return false; u.pm = pm; u.pn = pn; return true; }
    __device__ __forceinline__ void a_ready(const Unit&) const {}
    __device__ __forceinline__ void done(const Unit&) const {}
};
struct GluOrder { int first, step, count, gx;
    __device__ __forceinline__ bool next(int i, Unit& u) const { if (i >= count) return false; const int uu = first + step * i; u.pm = 32 * gx + (uu >> 1); u.pn = uu & 1; return true; }
    __device__ __forceinline__ void a_ready(const Unit&) const {}
    __device__ __forceinline__ void done(const Unit&) const {}
};
struct FourUnits { int pm0, gx;
    __device__ __forceinline__ bool next(int i, Unit& u) const { if (i > 3) return false; const int idx = pm0 + i; u.pm = (idx >> 1) * 16 + 2 * gx + (idx & 1); u.pn = 0; return true; }
    __device__ __forceinline__ void a_ready(const Unit&) const {}
    __device__ __forceinline__ void done(const Unit&) const {}
};
struct OneUnit { int pm;
    __device__ __forceinline__ bool next(int i, Unit& u) const { if (i > 0) return false; u.pm = pm; u.pn = 0; return true; }
    __device__ __forceinline__ void a_ready(const Unit&) const {}
    __device__ __forceinline__ void done(const Unit&) const {}
};
struct EpiXS { static constexpr int KSCALE_T = -1; static constexpr bool AFTER_DRAIN = true; static constexpr bool PERM = false;
    const float2* at; bf16* aext;
    __device__ __forceinline__ void fused(const f32x4 (&acc)[2][2][4][2], const Unit& u, int wr, int wc, int fr, int fq, LAS unsigned char* lds, int tid) const {
        LAS float* X = (LAS float*)lds;
#pragma unroll
        for (int ai = 0; ai < 2; ++ai)
#pragma unroll
            for (int m = 0; m < 4; ++m) { const int r = ai * 128 + wr * 64 + m * 16 + fr;
#pragma unroll
                for (int n = 0; n < 2; ++n) { const int ch = (8 * wc + 4 * n + fq) ^ (r & 7); *(LAS f32x4*)(X + r * 128 + ch * 4) = acc[ai][0][m][n]; } }
        __syncthreads();
        const int sq = tid & 127, qd = tid >> 7, bb = sq >> 6, p = sq & 63, g = u.pm >> 4, bp = u.pm & 15;
        const float2 A = at[g * 64 + p];
        typedef float f2v __attribute__((ext_vector_type(2)));
        LAS f2v* T = (LAS f2v*)(lds + RING_BYTES + 1024);
        const int r0 = bb * 128 + 32 * qd;
#define XS_AT(row, col) X[(row) * 128 + ((((col) >> 2) ^ ((row) & 7)) << 2) + ((col) & 3)]
        float sr = 0.f, si = 0.f;
#pragma unroll 8
        for (int c = 0; c < 32; ++c) { const float xr = XS_AT(r0 + c, p), xi = XS_AT(r0 + c, 64 + p); const float nr = A.x * sr - A.y * si + xr, ni = A.x * si + A.y * sr + xi; sr = nr; si = ni; }
        T[qd * 128 + sq] = (f2v){sr, si};
        __syncthreads();
        float2 A32 = A;
#pragma unroll
        for (int k = 0; k < 5; ++k) A32 = make_float2(A32.x * A32.x - A32.y * A32.y, 2.0f * A32.x * A32.y);
        sr = 0.f; si = 0.f;
        for (int q2 = 0; q2 < qd; ++q2) { const f2v t = T[q2 * 128 + sq]; const float nr = A32.x * sr - A32.y * si + t.x, ni = A32.x * si + A32.y * sr + t.y; sr = nr; si = ni; }
        bf16* ae = aext + ((size_t)g * 4096 + (size_t)(2 * bp + bb) * 128 + 32 * qd) * AEXT_LD + 256 + p;
#pragma unroll 8
        for (int c = 0; c < 32; ++c) { ae[(size_t)c * AEXT_LD] = (bf16)f2bf(sr); ae[(size_t)c * AEXT_LD + 64] = (bf16)f2bf(si);
            const float xr = XS_AT(r0 + c, p), xi = XS_AT(r0 + c, 64 + p); const float nr = A.x * sr - A.y * si + xr, ni = A.x * si + A.y * sr + xi; sr = nr; si = ni; }
#undef XS_AT
        asm volatile("s_waitcnt vmcnt(0)" ::: "memory");
        __syncthreads();
        if (tid == 0) { __builtin_amdgcn_fence(__ATOMIC_ACQUIRE, "agent"); asm volatile("s_waitcnt vmcnt(0)" ::: "memory"); }
        __syncthreads();
    }
};
struct EpiY { static constexpr int KSCALE_T = -1; static constexpr bool AFTER_DRAIN = false; static constexpr bool PERM = true;
    bf16* yg;
    __device__ __forceinline__ void operator()(const f32x4 (&acc)[2][2][4][2], const Unit& u, int wr, int wc, int fr, int fq) const {
        const int row0 = u.pm * 256 + wr * 64 + fr, cb = wc * 32 + 8 * fq;
        const int g = row0 >> 12;
        const unsigned cpart = (unsigned)(g >> 2) * 32768u + (unsigned)((g & 3) * 16 + (cb & 15)) * 2u;
        char* base = (char*)yg;
#pragma unroll
        for (int ai = 0; ai < 2; ++ai)
#pragma unroll
            for (int m = 0; m < 4; ++m) { const int R = row0 + ai * 128 + m * 16; const unsigned tok0 = (unsigned)(((R >> 7) & 31) * SEQ + (R & 127) * 16);
#pragma unroll
                for (int bj = 0; bj < 2; ++bj) { const f32x4 a0 = acc[ai][bj][m][0], a1 = acc[ai][bj][m][1]; const unsigned token = tok0 + (unsigned)((bj * 128 + cb) >> 4);
                    const f2p g0 = gelu_tanh2((f2p){a0[0], a0[1]}), g1 = gelu_tanh2((f2p){a0[2], a0[3]}), g2 = gelu_tanh2((f2p){a1[0], a1[1]}), g3 = gelu_tanh2((f2p){a1[2], a1[3]});
                    v4u w; w.x = pk2(g0.x, g0.y); w.y = pk2(g1.x, g1.y); w.z = pk2(g2.x, g2.y); w.w = pk2(g3.x, g3.y);
                    *(v4u*)(base + ((token >> 8) * 262144u + (token & 255u) * 128u + cpart)) = w; }
                asm volatile("" ::: "memory"); }
    }
};
struct EpiGlu { static constexpr int KSCALE_T = -1; static constexpr bool AFTER_DRAIN = false; static constexpr bool PERM = true;
    const bf16* yg; const float* bias; bf16* amix; u64* rs5; float zm;
    __device__ __forceinline__ void operator()(const f32x4 (&acc)[2][2][4][2], const Unit& u, int wr, int wc, int fr, int fq) const {
        const int row0 = u.pm * 256 + wr * 64 + fr, cb = u.pn * 256 + wc * 32 + 8 * fq;
        f32x4 bv[2][2];
#pragma unroll
        for (int bj = 0; bj < 2; ++bj)
#pragma unroll
            for (int n = 0; n < 2; ++n) bv[bj][n] = *(const f32x4*)(bias + cb + bj * 128 + 4 * n);
#pragma unroll
        for (int ai = 0; ai < 2; ++ai) {
            v4u yv[4][2];
#pragma unroll
            for (int m = 0; m < 4; ++m)
#pragma unroll
                for (int bj = 0; bj < 2; ++bj) yv[m][bj] = *(const v4u*)((const char*)yg + yg_addr((unsigned)(row0 + ai * 128 + m * 16), (unsigned)(cb + bj * 128)));
            asm volatile("" ::: "memory");
#pragma unroll
            for (int m = 0; m < 4; ++m) { const int row = row0 + ai * 128 + m * 16; float ss = 0.f;
#pragma unroll
                for (int bj = 0; bj < 2; ++bj) { const int col = cb + bj * 128; const v4u yq = yv[m][bj];
                    const f32x4 p0 = acc[ai][bj][m][0] + bv[bj][0], p1 = acc[ai][bj][m][1] + bv[bj][1];
                    const f2p ya = (f2p){bf_lo(yq.x), bf_hi(yq.x)} * sigmoid2((f2p){p0[0], p0[1]}), yb = (f2p){bf_lo(yq.y), bf_hi(yq.y)} * sigmoid2((f2p){p0[2], p0[3]});
                    const f2p yc = (f2p){bf_lo(yq.z), bf_hi(yq.z)} * sigmoid2((f2p){p1[0], p1[1]}), yd = (f2p){bf_lo(yq.w), bf_hi(yq.w)} * sigmoid2((f2p){p1[2], p1[3]});
                    const f2p sq = (ya * ya + yb * yb) + (yc * yc + yd * yd); ss += sq.x + sq.y;
                    v4u w; w.x = pk2(ya.x, ya.y); w.y = pk2(yb.x, yb.y); w.z = pk2(yc.x, yc.y); w.w = pk2(yd.x, yd.y);
                    *(v4u*)((char*)amix + amix_addr((size_t)row, (unsigned)col)) = w; }
                ss += __shfl_xor(ss, 16); ss += __shfl_xor(ss, 32);
                if (fq == 0) rs_add(rs5, row, ss * zm); }
            asm volatile("" ::: "memory"); }
    }
};
template <bool KS> struct EpiRes { static constexpr int KSCALE_T = KS ? 6 : -1; static constexpr bool AFTER_DRAIN = false; static constexpr bool PERM = true;
    bf16* xb; const u64* rs_in; u64* rs_out; float zm;
    __device__ __forceinline__ void kscale(f32x4 (&acc)[2][2][4][2], const Unit& u, int wr, int fr) const {
        const int row0 = u.pm * 256 + wr * 64 + fr; float sv[2][4]; rs_get8(rs_in, row0, sv);
#pragma unroll
        for (int ai = 0; ai < 2; ++ai)
#pragma unroll
            for (int m = 0; m < 4; ++m) { const float sc = rsqrtf(sv[ai][m] * (1.0f / 512.0f) + EPS);
#pragma unroll
                for (int bj = 0; bj < 2; ++bj)
#pragma unroll
                    for (int n = 0; n < 2; ++n) acc[ai][bj][m][n] = acc[ai][bj][m][n] * sc; }
    }
    __device__ __forceinline__ void operator()(const f32x4 (&acc)[2][2][4][2], const Unit& u, int wr, int wc, int fr, int fq) const {
        const int row0 = u.pm * 256 + wr * 64 + fr, cb = u.pn * 256 + wc * 32 + 8 * fq;
        char* xbb = (char*)xb;
        const float sc = zm;
#pragma unroll
        for (int ai = 0; ai < 2; ++ai) { float ssm[4];
            v4u xv[4][2];
#pragma unroll
            for (int m = 0; m < 4; ++m)
#pragma unroll
                for (int bj = 0; bj < 2; ++bj) xv[m][bj] = *(const v4u*)(xbb + xb_off((unsigned)(row0 + ai * 128 + m * 16), (unsigned)(cb + bj * 128)));
            asm volatile("" ::: "memory");
#pragma unroll
            for (int m = 0; m < 4; ++m) { const int row = row0 + ai * 128 + m * 16; float ss = 0.f;
#pragma unroll
                for (int bj = 0; bj < 2; ++bj) { const v4u xq = xv[m][bj]; const f32x4 a0 = acc[ai][bj][m][0] * sc, a1 = acc[ai][bj][m][1] * sc;
                    v4u w; w.x = pk2(bf_lo(xq.x) + a0[0], bf_hi(xq.x) + a0[1]); w.y = pk2(bf_lo(xq.y) + a0[2], bf_hi(xq.y) + a0[3]); w.z = pk2(bf_lo(xq.z) + a1[0], bf_hi(xq.z) + a1[1]); w.w = pk2(bf_lo(xq.w) + a1[2], bf_hi(xq.w) + a1[3]);
                    *(v4u*)(xbb + xb_off((unsigned)row, (unsigned)(cb + bj * 128))) = w;
                    const float r0 = bf_lo(w.x), r1 = bf_hi(w.x), r2 = bf_lo(w.y), r3 = bf_hi(w.y), r4 = bf_lo(w.z), r5 = bf_hi(w.z), r6 = bf_lo(w.w), r7 = bf_hi(w.w);
                    ss += (r0 * r0 + r1 * r1) + (r2 * r2 + r3 * r3) + (r4 * r4 + r5 * r5) + (r6 * r6 + r7 * r7); }
                ss += __shfl_xor(ss, 16); ss += __shfl_xor(ss, 32); ssm[m] = ss; }
            const float mine = (fq == 0) ? ssm[0] : (fq == 1) ? ssm[1] : (fq == 2) ? ssm[2] : ssm[3];
            rs_add(rs_out, row0 + ai * 128 + fq * 16, mine * zm);
            asm volatile("" ::: "memory"); }
    }
};
struct EpiFfn { static constexpr int KSCALE_T = -1; static constexpr bool AFTER_DRAIN = false; static constexpr bool PERM = true;
    const u64* rowsq; bf16* hid; mutable float rsv[2][4]; mutable int cpm;
    __device__ __forceinline__ void operator()(const f32x4 (&acc)[2][2][4][2], const Unit& u, int wr, int wc, int fr, int fq) const {
        const int row0 = u.pm * 256 + wr * 64 + fr, cb = u.pn * 128 + wc * 32 + 8 * fq;
        if (u.pm != cpm) { rs_get8(rowsq, row0, rsv); cpm = u.pm; }
#pragma unroll
        for (int ai = 0; ai < 2; ++ai)
#pragma unroll
            for (int m = 0; m < 4; ++m) { const int row = row0 + ai * 128 + m * 16; const float rs = rsqrtf(rsv[ai][m] * (1.0f / D) + EPS);
                typedef float f2p __attribute__((ext_vector_type(2)));
                const float rsn = rs * -1.4426950409f, rs2 = rs * rs; const f2p rsn2 = {rsn, rsn}, rsq2 = {rs2, rs2}, one2 = {1.0f, 1.0f};
                unsigned hw[4];
#pragma unroll
                for (int n = 0; n < 2; ++n)
#pragma unroll
                    for (int j = 0; j < 2; ++j) { const f2p g2 = {acc[ai][0][m][n][2 * j], acc[ai][0][m][n][2 * j + 1]}, u2 = {acc[ai][1][m][n][2 * j], acc[ai][1][m][n][2 * j + 1]};
                        const f2p t2 = g2 * rsn2; f2p e2; e2.x = __builtin_amdgcn_exp2f(t2.x); e2.y = __builtin_amdgcn_exp2f(t2.y);
                        const f2p d2 = e2 + one2; f2p r2; r2.x = __builtin_amdgcn_rcpf(d2.x); r2.y = __builtin_amdgcn_rcpf(d2.y);
                        const f2p h2 = ((g2 * u2) * rsq2) * r2; hw[2 * n + j] = pk2(h2.x, h2.y); }
                v4u w; w.x = hw[0]; w.y = hw[1]; w.z = hw[2]; w.w = hw[3];
                *(v4u*)((char*)hid + (size_t)(row >> 8) * ((size_t)256 * DFF * 2) + (size_t)(cb >> 6) * (256 * 128) + (size_t)(row & 255) * 128 + (cb & 63) * 2) = w;
                asm volatile("" ::: "memory"); }
    }
};

struct Args { const float* in[22]; float* out; unsigned char* ws; int ph_lo, ph_hi; };
typedef const Args __attribute__((address_space(4)))* KArgs;
__device__ __forceinline__ KArgs kargs() { KArgs p = (KArgs)__builtin_amdgcn_kernarg_segment_ptr(); asm volatile("" : "+s"(p)); return p; }
enum { I_X = 0, I_NORM_MIX, I_W_IN, I_LAM_RE, I_LAM_IM, I_B_RE, I_B_IM, I_C_RE, I_C_IM, I_S5D, I_LOGSTEP, I_WGLU, I_BGLU, I_S5NORM, I_WGATE, I_BGATE, I_GLANORM, I_WOUT, I_NORM_FFN, I_WFFN_IN, I_WFFN_OUT, I_NORM_FINAL };

__device__ __forceinline__ float wave_sum(float v) {
#pragma unroll
    for (int o = 1; o < 64; o <<= 1) v += __shfl_xor(v, o);
    return v;
}
__device__ __forceinline__ void transpose_item(const float* W, int ldn, int k0, int nsrc0, bf16* WT, int ldk, int ndst0, const float* scale, LAS float* scr, int lane) {
    float wv[32], sv[32];
#pragma unroll
    for (int i = 0; i < 32; ++i) { const int kk = 2 * i + (lane >> 5); wv[i] = W[(size_t)(k0 + kk) * ldn + nsrc0 + (lane & 31)]; sv[i] = scale ? scale[k0 + kk] : 1.0f; }
#pragma unroll
    for (int i = 0; i < 32; ++i) { const int kk = 2 * i + (lane >> 5); scr[kk * 33 + (lane & 31)] = wv[i] * sv[i]; }
    LDS_WAIT(); asm volatile("" ::: "memory");
    const int c = lane & 7;
#pragma unroll
    for (int j = 0; j < 4; ++j) { const int n = (lane >> 3) + 8 * j; const LAS float* s = scr + (8 * c) * 33 + n;
        v4u o; o.x = pk2(s[0 * 33], s[1 * 33]); o.y = pk2(s[2 * 33], s[3 * 33]); o.z = pk2(s[4 * 33], s[5 * 33]); o.w = pk2(s[6 * 33], s[7 * 33]);
        *(GAS v4u*)(WT + (size_t)(ndst0 + n) * ldk + k0 + 8 * c) = o; }
    LDS_WAIT(); asm volatile("" ::: "memory");
}

__device__ __forceinline__ void s5_tables(LAS unsigned char* lds, KArgs a, int l, int g, int half, int tid) {
    typedef double d2 __attribute__((ext_vector_type(2))); typedef float f2 __attribute__((ext_vector_type(2)));
    LAS d2* ap = (LAS d2*)lds;
    LAS f2* apf = (LAS f2*)(lds + 17408);
    LAS f2* Bb = (LAS f2*)(lds + 17408 + 8704);
    LAS f2* Cc = (LAS f2*)(lds + 17408 + 8704 + 8192);
    LAS float* Kt = (LAS float*)(lds + 17408 + 8704 + 16384);
    const int lg = l * 32 + g;
    const double step = exp((double)a->in[I_LOGSTEP][lg]);
    const float* lre = a->in[I_LAM_RE] + lg * 64; const float* lim = a->in[I_LAM_IM] + lg * 64;
#define S5_CEXP(lr_, li_, t_, re_, im_) do { const double x_ = (double)(lr_) * (t_), ang_ = (double)(li_) * (t_); const double k_ = rint(ang_ * 0.15915494309189535); \
        const float r_ = (float)fma(-k_, 6.283185307179586, ang_), m_ = expf((float)x_); re_ = m_ * cosf(r_); im_ = m_ * sinf(r_); } while (0)
    for (int i = tid; i < 64 * 17; i += 512) { const int p = i / 17, dl = i % 17; float vr, vi; S5_CEXP(lre[p], lim[p], step * dl, vr, vi); ap[i] = (d2){(double)vr, (double)vi}; apf[i] = (f2){vr, vi}; }
    for (int i = tid; i < 1024; i += 512) { const int p = i >> 4; const double lr = lre[p], li = lim[p]; float arf, aif; S5_CEXP(lre[p], lim[p], step, arf, aif); const double ar = arf, ai = aif, den = lr * lr + li * li;
        const double fr = ((ar - 1.0) * lr + ai * li) / den, fi = (ai * lr - (ar - 1.0) * li) / den; const double br = a->in[I_B_RE][(size_t)lg * 1024 + i], bi = a->in[I_B_IM][(size_t)lg * 1024 + i];
        Bb[i] = (f2){(float)(fr * br - fi * bi), (float)(fr * bi + fi * br)}; }
#undef S5_CEXP
    for (int i = tid; i < 1024; i += 512) Cc[i] = (f2){a->in[I_C_RE][(size_t)lg * 1024 + i], a->in[I_C_IM][(size_t)lg * 1024 + i]};
    __syncthreads();
    LAS f2* CA = (LAS f2*)(lds + 60416);
    for (int i = tid; i < 8 * 64 * 16; i += 512) { const int dl = i & 15, p = (i >> 4) & 63, h8 = i >> 10; const f2 c = Cc[(8 * half + h8) * 64 + p], av = apf[p * 17 + dl]; CA[i] = (f2){c.x * av.x - c.y * av.y, c.x * av.y + c.y * av.x}; }
    __syncthreads();
    for (int i = tid; i < 2048; i += 512) { const int dl = i >> 7, h8 = (i >> 4) & 7, h = 8 * half + h8, hp = i & 15; float s = 0.f;
#pragma unroll 8
        for (int p = 0; p < 64; ++p) { const f2 ca = CA[(h8 * 64 + p) * 16 + dl], bv = Bb[p * 16 + hp]; s += ca.x * bv.x - ca.y * bv.y; }
        if (dl == 0 && h == hp) s += a->in[I_S5D][l * 512 + g * 16 + h];
        Kt[dl * 256 + h * 16 + hp] = s; }
    __syncthreads();
    bf16* wx = (bf16*)(a->ws + WS_WX) + (size_t)lg * 256 * 256; bf16* wy = (bf16*)(a->ws + WS_WY) + (size_t)lg * 256 * 384;
    for (int i = tid; i < 128 * 32; i += 512) { const int nl = i >> 5, k0 = (i & 31) * 8; const int n = (nl & 63) + 64 * half + 128 * (nl >> 6); v4u o = (v4u){0u, 0u, 0u, 0u};
        if (n < 128) { const int p = n & 63, im = n >> 6; float v[8];
#pragma unroll
            for (int e = 0; e < 8; ++e) { const int k = k0 + e, tau = k >> 4, hp = k & 15; const f2 av = apf[p * 17 + 15 - tau], bv = Bb[p * 16 + hp]; v[e] = im ? (av.x * bv.y + av.y * bv.x) : (av.x * bv.x - av.y * bv.y); }
            o.x = pk2(v[0], v[1]); o.y = pk2(v[2], v[3]); o.z = pk2(v[4], v[5]); o.w = pk2(v[6], v[7]); }
        *(v4u*)(wx + (size_t)n * 256 + k0) = o; }
    for (int i = tid; i < 128 * 48; i += 512) { const int nl = i / 48, k0 = (i % 48) * 8, t = nl >> 3, h = 8 * half + (nl & 7), n = t * 16 + h; float v[8];
#pragma unroll
        for (int e = 0; e < 8; ++e) { const int k = k0 + e;
            if (k < 256) { const int tau = k >> 4, hp = k & 15; v[e] = (tau <= t) ? Kt[(t - tau) * 256 + h * 16 + hp] : 0.0f; }
            else { const int p = (k - 256) & 63, im = (k - 256) >> 6; const f2 c = Cc[h * 64 + p], av = apf[p * 17 + t + 1]; v[e] = im ? -(c.x * av.y + c.y * av.x) : (c.x * av.x - c.y * av.y); } }
        v4u o; o.x = pk2(v[0], v[1]); o.y = pk2(v[2], v[3]); o.z = pk2(v[4], v[5]); o.w = pk2(v[6], v[7]);
        *(v4u*)(wy + (size_t)n * 384 + k0) = o; }
    if (half == 0 && tid < 64) { const d2 av = ap[tid * 17 + 16]; ((float2*)(a->ws + WS_AT))[lg * 64 + tid] = make_float2((float)av.x, (float)av.y); }
    __syncthreads();
}

__device__ __forceinline__ void p0_prologue(LAS unsigned char* lds, KArgs a, int tid, int lane, int wave) {
    asm volatile("" : "+v"(tid), "+v"(lane));
    const int G = gridDim.x, gw = blockIdx.x * NWAVES + wave, NGW = G * NWAVES;
    const bool tables_first = ((blockIdx.x >> 3) & 1) != 0;
    if (tables_first) for (int it = blockIdx.x; it < DEPTH * 32 * 2; it += G) s5_tables(lds, a, it >> 6, (it >> 1) & 31, it & 1, tid);
    LAS float* scr = (LAS float*)(lds + RING_OFF + wave * 16384);
    constexpr int IT_IN = 16 * 64, IT_GLU = 8 * 16, IT_OUT = 16 * 32, IT_F1 = 16 * 176, IT_F2 = 44 * 32, IT_L = IT_IN + IT_GLU + IT_OUT + IT_F1 + IT_F2;
    for (int it = gw; it < DEPTH * IT_L; it += NGW) {
        const int l = it / IT_L; int r = it % IT_L;
        if (r < IT_IN) { const int kb = r >> 6, nb = r & 63; transpose_item(a->in[I_W_IN] + (size_t)l * D * D_IN_SRC, D_IN_SRC, 64 * kb, 32 * nb, (bf16*)(a->ws + WS_W1) + (size_t)l * NIN * D, D, 32 * nb, a->in[I_NORM_MIX] + l * D, scr, lane); continue; } r -= IT_IN;
        if (r < IT_GLU) { const int kb = r >> 4, nb = r & 15; transpose_item(a->in[I_WGLU] + (size_t)l * 512 * 512, 512, 64 * kb, 32 * nb, (bf16*)(a->ws + WS_WG) + (size_t)l * 512 * 512, 512, 32 * nb, nullptr, scr, lane); continue; } r -= IT_GLU;
        if (r < IT_OUT) { const int kb = r >> 5, nb = r & 31; const float* sc = (kb < 8) ? (a->in[I_S5NORM] + l * 512) : (a->in[I_GLANORM] + l * 512 - 512);
            transpose_item(a->in[I_WOUT] + (size_t)l * D * D, D, 64 * kb, 32 * nb, (bf16*)(a->ws + WS_WO) + (size_t)l * D * D, D, 32 * nb, sc, scr, lane); continue; } r -= IT_OUT;
        if (r < IT_F1) { const int kb = r / 176, nb = r % 176; const int nd = 32 * nb, pn = nd >> 8, bj = (nd >> 7) & 1, c0 = nd & 127; const int ns = bj * DFF + 128 * pn + c0;
            transpose_item(a->in[I_WFFN_IN] + (size_t)l * D * NFF2, NFF2, 64 * kb, ns, (bf16*)(a->ws + WS_WF1) + (size_t)l * NFF2 * D, D, nd, a->in[I_NORM_FFN] + l * D, scr, lane); continue; } r -= IT_F1;
        { const int kb = r >> 5, nb = r & 31; transpose_item(a->in[I_WFFN_OUT] + (size_t)l * DFF * D, D, 64 * kb, 32 * nb, (bf16*)(a->ws + WS_WF2) + (size_t)l * D * DFF, DFF, 32 * nb, nullptr, scr, lane); }
    }
    for (int it = blockIdx.x * 512 + tid; it < DEPTH * 256 * 128; it += G * 512) { const int l = it >> 15, n = (it >> 7) & 255, k0 = (it & 127) * 8;
        float wg[16];
#pragma unroll
        for (int r = 0; r < 16; ++r) wg[r] = a->in[I_WGATE][(size_t)l * 16 * 256 + r * 256 + n];
        float v[8];
#pragma unroll
        for (int e = 0; e < 8; ++e) { const float* wr = a->in[I_W_IN] + ((size_t)l * D + k0 + e) * D_IN_SRC + 2048; float s = 0.f;
#pragma unroll
            for (int r = 0; r < 16; ++r) s += wr[r] * wg[r];
            v[e] = s * a->in[I_NORM_MIX][l * D + k0 + e]; }
        v4u o; o.x = pk2(v[0], v[1]); o.y = pk2(v[2], v[3]); o.z = pk2(v[4], v[5]); o.w = pk2(v[6], v[7]);
        *(v4u*)((bf16*)(a->ws + WS_W1) + ((size_t)l * NIN + 2048 + n) * D + k0) = o; }
    u64* rs = (u64*)(a->ws + WS_RS);
    for (int m = gw; m < M; m += 4 * NGW) {
        f32x4 v[4][4];
#pragma unroll
        for (int r = 0; r < 4; ++r) { const GAS f32x4* xr = (const GAS f32x4*)(a->in[I_X] + (size_t)(m + r * NGW) * D) + lane;
#pragma unroll
            for (int j = 0; j < 4; ++j) v[r][j] = xr[64 * j]; }
#pragma unroll
        for (int r = 0; r < 4; ++r) { float s = 0.f; GAS char* ob = (GAS char*)(a->ws + WS_XB);
#pragma unroll
            for (int j = 0; j < 4; ++j) { const v2u w = (v2u){pk2(v[r][j].x, v[r][j].y), pk2(v[r][j].z, v[r][j].w)}; *(GAS v2u*)(ob + xb_off((unsigned)(m + r * NGW), (unsigned)(4 * lane + 256 * j))) = w; const float r0 = bf_lo(w.x), r1 = bf_hi(w.x), r2 = bf_lo(w.y), r3 = bf_hi(w.y); s += (r0 * r0 + r1 * r1) + (r2 * r2 + r3 * r3); }
            s = wave_sum(s);
            if (lane == 0) rs[m + r * NGW] = (u64)(s * 16777216.0f); } }
    for (size_t i = (size_t)blockIdx.x * 512 + tid; i < (size_t)12 * M / 2; i += (size_t)G * 512) ((v4u*)(rs + M))[i] = (v4u){0u, 0u, 0u, 0u};
    if (!tables_first) { __syncthreads(); for (int it = blockIdx.x; it < DEPTH * 32 * 2; it += G) s5_tables(lds, a, it >> 6, (it >> 1) & 31, it & 1, tid); }
}

constexpr int GP = 72;
constexpr int GL_QD = 0, GL_KI = 9216, GL_KET = 18432, GL_VT = 27648, GL_P = 46080, GL_DEC = 55296, GL_PS = 55552, GL_OW = 57600, GL_OWP = 20, GL_YT = 98560, GL_YTP = 272;
template <int CTRL, int ROWMASK> __device__ __forceinline__ float dpp0(float v) { return __builtin_bit_cast(float, __builtin_amdgcn_update_dpp(0, __builtin_bit_cast(int, v), CTRL, ROWMASK, 0xF, false)); }
__device__ __forceinline__ float wave_incl_scan(float v) {
    v += dpp0<0x111, 0xF>(v); v += dpp0<0x112, 0xF>(v); v += dpp0<0x114, 0xF>(v); v += dpp0<0x118, 0xF>(v);
    v += dpp0<0x142, 0xA>(v); v += dpp0<0x143, 0xC>(v); return v;
}
struct GlaIn { v4u gt, q, k, v0, v1, g0, g1; };
__device__ __forceinline__ void gla_load(GlaIn& x, const bf16* zb, size_t token, int h, int w) {
    const char* zr = (const char*)zb + zb_blob(token, h); const int tl = (int)(token & 63);
    x.gt = *(const v4u*)(zr + ZB_GATE + w * 1024 + tl * 16); x.q = *(const v4u*)(zr + ZB_Q + w * 1024 + tl * 16); x.k = *(const v4u*)(zr + ZB_K + w * 1024 + tl * 16);
    x.v0 = *(const v4u*)(zr + ZB_V + w * 2048 + tl * 16); x.v1 = *(const v4u*)(zr + ZB_V + w * 2048 + 1024 + tl * 16);
    x.g0 = *(const v4u*)(zr + ZB_G + w * 2048 + tl * 16); x.g1 = *(const v4u*)(zr + ZB_G + w * 2048 + 1024 + tl * 16);
}
__device__ __forceinline__ void unpack8(const v4u p, float (&o)[8]) { o[0] = bf_lo(p.x); o[1] = bf_hi(p.x); o[2] = bf_lo(p.y); o[3] = bf_hi(p.y); o[4] = bf_lo(p.z); o[5] = bf_hi(p.z); o[6] = bf_lo(p.w); o[7] = bf_hi(p.w); }
__device__ __forceinline__ void gla_phase(LAS unsigned char* lds, KArgs a, int l, int tid, int b, int h) {
    asm volatile("" : "+v"(tid));
    const int lane = tid & 63, w = __builtin_amdgcn_readfirstlane(tid >> 6), q = lane >> 4, r16 = lane & 15;
    LAS bf16* QD = (LAS bf16*)(lds + GL_QD); LAS bf16* KI = (LAS bf16*)(lds + GL_KI); LAS bf16* KET = (LAS bf16*)(lds + GL_KET); LAS bf16* VT = (LAS bf16*)(lds + GL_VT); LAS bf16* P = (LAS bf16*)(lds + GL_P);
    LAS float* DEC = (LAS float*)(lds + GL_DEC); LAS float* PS = (LAS float*)(lds + GL_PS); LAS float* OW = (LAS float*)(lds + GL_OW) + w * (64 * GL_OWP);
    const bf16* zb = (const bf16*)(a->ws + WS_HID); bf16* amix = (bf16*)(a->ws + WS_HID);
    float bg[8];
#pragma unroll
    for (int e = 0; e < 8; ++e) bg[e] = a->in[I_BGATE][l * 256 + 64 * h + 8 * w + e];
    f32x4 Sacc[4];
#pragma unroll
    for (int T = 0; T < 4; ++T) Sacc[T] = (f32x4){0.f, 0.f, 0.f, 0.f};
    GlaIn cur, nxt;
    gla_load(cur, zb, (size_t)b * SEQ + lane, h, w);
    float ov[16]; v4u pg0 = (v4u){0u, 0u, 0u, 0u}, pg1 = pg0;
#pragma unroll
    for (int e = 0; e < 16; ++e) ov[e] = 0.f;
#define GLA_OUT(ntok) do {     \
            float ss_ = 0.f; _Pragma("unroll") for (int ww = 0; ww < 8; ++ww) ss_ += PS[ww * 64 + lane]; \
            const float sc_ = rsqrtf(ss_ * (1.0f / 128.0f) + EPS); \
            float g_[16]; { float t8[8]; unpack8(pg0, t8); _Pragma("unroll") for (int e = 0; e < 8; ++e) g_[e] = t8[e]; unpack8(pg1, t8); _Pragma("unroll") for (int e = 0; e < 8; ++e) g_[8 + e] = t8[e]; } \
            float y_[16]; _Pragma("unroll") for (int e = 0; e < 16; ++e) y_[e] = g_[e] * fsigmoid(g_[e]) * ov[e] * sc_; \
            LAS v4u* yt_ = (LAS v4u*)(lds + GL_YT + lane * GL_YTP + w * 32); (void)(ntok); \
            yt_[0] = (v4u){pk2(y_[0], y_[1]), pk2(y_[2], y_[3]), pk2(y_[4], y_[5]), pk2(y_[6], y_[7])}; \
            yt_[1] = (v4u){pk2(y_[8], y_[9]), pk2(y_[10], y_[11]), pk2(y_[12], y_[13]), pk2(y_[14], y_[15])}; } while (0)
#define GLA_FLUSH(tok0) do { _Pragma("unroll") for (int k_ = 0; k_ < 2; ++k_) { const int id_ = tid + 512 * k_, row_ = id_ >> 4, pc_ = id_ & 15; \
            const v4u v_ = *(const LAS v4u*)(lds + GL_YT + row_ * GL_YTP + pc_ * 16); \
            *(v4u*)((char*)amix + amix_addr((tok0) + (size_t)row_, (unsigned)(512 + 128 * h + 8 * pc_))) = v_; } } while (0)
    for (int n = 0; n < 32; ++n) {
        const size_t token = (size_t)b * SEQ + n * 64 + lane;
        GLA_OUT(n > 0 ? token - 64 : token);
        gla_load(nxt, zb, (size_t)b * SEQ + (n + 1 < 32 ? n + 1 : 31) * 64 + lane, h, w);
        {
            float gx[8], qv[8], kv[8], cum[8];
            unpack8(cur.gt, gx); unpack8(cur.q, qv); unpack8(cur.k, kv);
#pragma unroll
            for (int e = 0; e < 8; ++e) { const float x = gx[e] + bg[e]; const float ex = __builtin_amdgcn_exp2f(-1.4426950409f * fabsf(x));
                const float ls2 = fmaf(fminf(x, 0.f), 1.4426950409f * (1.0f / 16.0f), (-1.0f / 16.0f) * __builtin_amdgcn_logf(1.0f + ex)); cum[e] = wave_incl_scan(ls2); }
            float qd[8], ki[8], ke[8];
#pragma unroll
            for (int e = 0; e < 8; ++e) { const float X = __builtin_amdgcn_exp2f(cum[e]);
                const float Xtot = __builtin_bit_cast(float, __builtin_amdgcn_readlane(__builtin_bit_cast(int, X), 63));
                qd[e] = qv[e] * 0.125f * X; ki[e] = kv[e] * __builtin_amdgcn_exp2f(-cum[e]); ke[e] = ki[e] * Xtot;
                if (lane == 63) DEC[8 * w + e] = X; }
            *(LAS v4u*)(QD + lane * GP + 8 * w) = (v4u){pk2(qd[0], qd[1]), pk2(qd[2], qd[3]), pk2(qd[4], qd[5]), pk2(qd[6], qd[7])};
            *(LAS v4u*)(KI + lane * GP + 8 * w) = (v4u){pk2(ki[0], ki[1]), pk2(ki[2], ki[3]), pk2(ki[4], ki[5]), pk2(ki[6], ki[7])};
#pragma unroll
            for (int e = 0; e < 8; ++e) KET[(8 * w + e) * GP + lane] = (bf16)f2bf(ke[e]);
            const unsigned vw[8] = {cur.v0.x, cur.v0.y, cur.v0.z, cur.v0.w, cur.v1.x, cur.v1.y, cur.v1.z, cur.v1.w};
#pragma unroll
            for (int e = 0; e < 8; ++e) { VT[(16 * w + 2 * e) * GP + lane] = (bf16)(vw[e] & 0xffffu); VT[(16 * w + 2 * e + 1) * GP + lane] = (bf16)(vw[e] >> 16); }
        }
        __syncthreads();
        GLA_FLUSH((size_t)b * SEQ + (size_t)(n > 0 ? n - 1 : 0) * 64);
        {
            const int ti = w >> 1;
            bf16x8 af[2][2], bf[2];
#pragma unroll
            for (int kk = 0; kk < 2; ++kk) { bf[kk] = *(const LAS bf16x8*)(QD + (16 * ti + r16) * GP + 32 * kk + 8 * q);
#pragma unroll
                for (int s2 = 0; s2 < 2; ++s2) af[s2][kk] = *(const LAS bf16x8*)(KI + (16 * (2 * (w & 1) + s2) + r16) * GP + 32 * kk + 8 * q); }
            __builtin_amdgcn_sched_barrier(0);
#pragma unroll
            for (int s2 = 0; s2 < 2; ++s2) { const int si = 2 * (w & 1) + s2; f32x4 acc = (f32x4){0.f, 0.f, 0.f, 0.f};
#pragma unroll
                for (int kk = 0; kk < 2; ++kk) acc = __builtin_amdgcn_mfma_f32_16x16x32_bf16(af[s2][kk], bf[kk], acc, 0, 0, 0);
                const int t = 16 * ti + r16, s0 = 16 * si + 4 * q;
                const float p0 = (s0 + 0 <= t) ? acc[0] : 0.f, p1 = (s0 + 1 <= t) ? acc[1] : 0.f, p2 = (s0 + 2 <= t) ? acc[2] : 0.f, p3 = (s0 + 3 <= t) ? acc[3] : 0.f;
                *(LAS v2u*)(P + t * GP + s0) = (v2u){pk2(p0, p1), pk2(p2, p3)}; }
        }
        __syncthreads();
        {
            f32x4 o[4];
            bf16x8 pf[4][2], vf[2], kf[4][2]; v2u qlo[4][2], qhi[4][2]; f32x4 d4[4];
#pragma unroll
            for (int kk = 0; kk < 2; ++kk) { vf[kk] = *(const LAS bf16x8*)(VT + (16 * w + r16) * GP + 32 * kk + 8 * q);
#pragma unroll
                for (int i = 0; i < 4; ++i) { pf[i][kk] = *(const LAS bf16x8*)(P + (16 * i + r16) * GP + 32 * kk + 8 * q);
                    qlo[i][kk] = *(const LAS v2u*)(QD + (16 * i + r16) * GP + 32 * kk + 4 * q); qhi[i][kk] = *(const LAS v2u*)(QD + (16 * i + r16) * GP + 32 * kk + 16 + 4 * q); } }
            __builtin_amdgcn_sched_barrier(0);
#pragma unroll
            for (int i = 0; i < 4; ++i) { o[i] = (f32x4){0.f, 0.f, 0.f, 0.f};
#pragma unroll
                for (int kk = 0; kk < 2; ++kk) if (32 * kk <= 16 * i + 15) o[i] = __builtin_amdgcn_mfma_f32_16x16x32_bf16(pf[i][kk], vf[kk], o[i], 0, 0, 0); }
#pragma unroll
            for (int T = 0; T < 4; ++T) { d4[T] = *(const LAS f32x4*)(DEC + 16 * T + 4 * q);
#pragma unroll
                for (int kk = 0; kk < 2; ++kk) kf[T][kk] = *(const LAS bf16x8*)(KET + (16 * T + r16) * GP + 32 * kk + 8 * q); }
#pragma unroll
            for (int kk = 0; kk < 2; ++kk) { const f32x4 s0 = Sacc[2 * kk], s1 = Sacc[2 * kk + 1]; v4u bw; bw.x = pk2(s0[0], s0[1]); bw.y = pk2(s0[2], s0[3]); bw.z = pk2(s1[0], s1[1]); bw.w = pk2(s1[2], s1[3]);
                const bf16x8 bfS = __builtin_bit_cast(bf16x8, bw);
#pragma unroll
                for (int i = 0; i < 4; ++i) { const bf16x8 af = __builtin_bit_cast(bf16x8, ((v4u){qlo[i][kk].x, qlo[i][kk].y, qhi[i][kk].x, qhi[i][kk].y}));
                    o[i] = __builtin_amdgcn_mfma_f32_16x16x32_bf16(af, bfS, o[i], 0, 0, 0); } }
#pragma unroll
            for (int i = 0; i < 4; ++i)
#pragma unroll
                for (int r = 0; r < 4; ++r) OW[(16 * i + 4 * q + r) * GL_OWP + r16] = o[i][r];
#pragma unroll
            for (int T = 0; T < 4; ++T) { Sacc[T] = Sacc[T] * d4[T];
#pragma unroll
                for (int kk = 0; kk < 2; ++kk) Sacc[T] = __builtin_amdgcn_mfma_f32_16x16x32_bf16(kf[T][kk], vf[kk], Sacc[T], 0, 0, 0); }
            float ss = 0.f;
#pragma unroll
            for (int c = 0; c < 4; ++c) { const f32x4 t4 = *(const LAS f32x4*)(OW + lane * GL_OWP + 4 * c); ov[4 * c] = t4[0]; ov[4 * c + 1] = t4[1]; ov[4 * c + 2] = t4[2]; ov[4 * c + 3] = t4[3];
                ss += (t4[0] * t4[0] + t4[1] * t4[1]) + (t4[2] * t4[2] + t4[3] * t4[3]); }
            PS[w * 64 + lane] = ss;
        }
        __syncthreads();
        pg0 = cur.g0; pg1 = cur.g1;
        cur = nxt;
    }
    GLA_OUT((size_t)b * SEQ + 31 * 64 + lane);
    __syncthreads();
    GLA_FLUSH((size_t)b * SEQ + (size_t)31 * 64);
#undef GLA_OUT
#undef GLA_FLUSH
    __syncthreads();
}

__device__ __forceinline__ void final_norm_panel(KArgs a, int pm, int lane, int wave) {
    asm volatile("" : "+v"(lane));
    const u64* rs = (const u64*)(a->ws + WS_RS) + (size_t)8 * M; const int rbase = pm * 256;
    f32x4 gn[4];
#pragma unroll
    for (int j = 0; j < 4; ++j) gn[j] = ((const f32x4*)a->in[I_NORM_FINAL])[64 * j + lane];
    for (int m = rbase + wave; m < rbase + 256; m += 4 * NWAVES) {
        v2u w[4][4]; float r[4];
#pragma unroll
        for (int q = 0; q < 4; ++q) { const GAS char* xbp = (const GAS char*)(a->ws + WS_XB); r[q] = rs_get(rs, m + q * NWAVES);
#pragma unroll
            for (int j = 0; j < 4; ++j) w[q][j] = *(const GAS v2u*)(xbp + xb_off((unsigned)(m + q * NWAVES), (unsigned)(4 * lane + 256 * j))); }
#pragma unroll
        for (int q = 0; q < 4; ++q) { GAS f32x4* orow = (GAS f32x4*)(a->out + (size_t)(m + q * NWAVES) * D) + lane; const float rr = rsqrtf(r[q] * (1.0f / D) + EPS);
#pragma unroll
            for (int j = 0; j < 4; ++j) { const f32x4 v = (f32x4){bf_lo(w[q][j].x), bf_hi(w[q][j].x), bf_lo(w[q][j].y), bf_hi(w[q][j].y)}; orow[64 * j] = v * rr * gn[j]; } } }
}

constexpr size_t CTL_YFLAG = 1536 * 1024 + 8192;
constexpr size_t CTL_TAIL = 1536 * 1024;
constexpr int TL_READY = 0, TL_NEXT = 64, TL_DONE = 128, TL_UNITS = 8;
#define TL_WAIT_CAP 600u
__device__ __forceinline__ unsigned tl_ld(unsigned* p) { return __hip_atomic_load(p, __ATOMIC_RELAXED, __HIP_MEMORY_SCOPE_AGENT); }
__device__ __forceinline__ int tl_claim(unsigned* tl, int myclass, int lane) {
    unsigned spins = 0;
    for (;;) {
        const unsigned nx = tl_ld(tl + TL_NEXT + lane), rd = tl_ld(tl + TL_READY + lane);
        const bool open = nx < (unsigned)TL_UNITS;
        const unsigned long long avail = __ballot(open && (rd != 0u || lane == myclass)), pending = __ballot(open);
        if (avail == 0ull) { if (pending == 0ull || ++spins > TL_WAIT_CAP) return -1; __builtin_amdgcn_s_sleep(32); continue; }
        int v;
        if ((avail >> myclass) & 1ull) v = myclass;
        else {
            unsigned long long pick = avail;
#pragma unroll
            for (int k = TL_UNITS - 1; k >= 0; --k) { const unsigned long long mk = __ballot(open && (rd != 0u) && nx == (unsigned)k); if (mk) pick = mk; }
            const unsigned long long rot = myclass ? ((pick >> myclass) | (pick << (64 - myclass))) : pick; v = (__builtin_ctzll(rot) + myclass) & 63; }
        unsigned u = 0u; if (lane == 0) u = __hip_atomic_fetch_add(tl + TL_NEXT + v, 1u, __ATOMIC_RELAXED, __HIP_MEMORY_SCOPE_AGENT);
        u = (unsigned)__builtin_amdgcn_readfirstlane((int)u);
        if (u < (unsigned)TL_UNITS) return v * TL_UNITS + (int)u;
    }
}
__device__ __forceinline__ unsigned tl_finish(unsigned* tl, volatile LAS unsigned* slot, int pm0, int pm1, int n) {
    asm volatile("s_waitcnt vmcnt(0)" ::: "memory");
    __syncthreads();
    if (threadIdx.x == 0) {
        __builtin_amdgcn_fence(__ATOMIC_RELEASE, "agent");
        asm volatile("s_waitcnt vmcnt(0)" ::: "memory");
        unsigned m = 0u;
        if (__hip_atomic_fetch_add(tl + TL_DONE + pm0, 1u, __ATOMIC_RELAXED, __HIP_MEMORY_SCOPE_AGENT) == 3u) m |= 1u;
        if (n > 1 && __hip_atomic_fetch_add(tl + TL_DONE + pm1, 1u, __ATOMIC_RELAXED, __HIP_MEMORY_SCOPE_AGENT) == 3u) m |= 2u;
        if (m) { __builtin_amdgcn_fence(__ATOMIC_ACQUIRE, "agent"); asm volatile("s_waitcnt vmcnt(0)" ::: "memory"); }
        slot[0] = m;
    }
    __syncthreads();
    return slot[0];
}

constexpr int PH_PER_LAYER = 6;
constexpr int N_PHASES = 2 + PH_PER_LAYER * DEPTH;

__global__ void __launch_bounds__(NWAVES * 64, 2) hymba_fwd(Args args) {
    extern __shared__ __attribute__((aligned(16))) unsigned char lds_raw[];
    LAS unsigned char* lds = (LAS unsigned char*)lds_raw;
    const int tid = threadIdx.x, lane = tid & 63, wave = __builtin_amdgcn_readfirstlane(tid >> 6);
    const int G = gridDim.x;
    volatile LAS unsigned* MISC = (volatile LAS unsigned*)(lds + MISC_OFF);
    for (int u = tid; u < (LDS_BYTES - LDSCTL_OFF) / 4; u += NWAVES * 64) ((LAS unsigned*)(lds + LDSCTL_OFF))[u] = 0u;
    __syncthreads();
    const int lo = args.ph_lo, hi = args.ph_hi;
    const int gx = blockIdx.x & 7, gj = blockIdx.x >> 3;
    unsigned* barw = (unsigned*)(args.ws + WS_CTL) + CW_BAR;
    const XcdBarrier bar = xcd_barrier_post(barw, MISC + 8, (unsigned)G);
    const XcdBarrier gbar = xcd_barrier_post(barw + (1 + gx) * XCD_BAR_WORDS, MISC + 12, (unsigned)(G / 8));
    XcdBarrier sbar = gbar;
    if (gj >= 16) sbar = xcd_barrier_post(barw + (9 + gx) * XCD_BAR_WORDS, MISC + 16, (unsigned)(G / 16));
    const XcdBarrier cbar = xcd_barrier_post(barw + (17 + gx * 8 + (gj & 7)) * XCD_BAR_WORDS, MISC + 20, 4u);
#ifndef PHM
#define PHM 0xFFFFu
#endif
#define IN(k) (lo <= (k) && (k) < hi)
#define HAS(j) ((PHM >> (j)) & 1u)
#ifndef PROBE_REP
#define PROBE_REP 0u
#endif
#define REP(j) for (int rep_ = 0, nrep_ = 1 + (int)((PROBE_REP >> (j)) & 1u); rep_ < nrep_; ++rep_)
#define ZM ((rep_ == nrep_ - 1) ? 1.0f : 0.0f)
#define SEAM(k) do { if (IN(k) && IN((k) + 1)) xcd_barrier(bar); } while (0)
#define SEAMG(k) do { if (IN(k) && IN((k) + 1)) xcd_barrier(gbar); } while (0)
#define SEAMC(k) do { if (IN(k) && IN((k) + 1)) xcd_barrier(cbar); } while (0)
#define SITE() KArgs ka = kargs(); unsigned char* ws = ka->ws; u64* rsq = (u64*)(ws + WS_RS); (void)rsq

    if (HAS(0) && IN(0)) REP(0) { p0_prologue(lds, kargs(), tid, lane, wave); }
    SEAM(0);

    for (int l = 0; l < DEPTH; ++l) {
        const int pb = 1 + PH_PER_LAYER * l;
        if (HAS(1) && IN(pb + 0)) REP(1) {
            SITE();
            pg8::Gemm g{(const bf16*)(ws + WS_XB), (const bf16*)(ws + WS_W1) + (size_t)l * NIN * D, M, NIN, D, 64, D, 30, 0, 30, 0, (size_t)32768, (size_t)524288};
            pg8::StaticOrder S; S.init(M, NIN, G, (int)blockIdx.x);
            EpiIn E{rsq + (size_t)(2 * l) * M, (bf16*)(ws + WS_AEXT), (bf16*)(ws + WS_HID)};
            pg8::gemm_phase<EpiIn, pg8::StaticOrder>(lds + RING_OFF, g, S, E);
        }
        SEAMG(pb + 0);
        if (HAS(2) && IN(pb + 1)) REP(2) {
            if (gj < 16) { gla_phase(lds + RING_OFF, kargs(), l, tid, 4 * gx + (gj >> 2), gj & 3);
                {
                    SITE();
                    unsigned* yflag = (unsigned*)(ws + WS_CTL + CTL_YFLAG) + gx * DEPTH + l;
                    if (tid == 0) { unsigned sp = 0; while (__hip_atomic_load(yflag, __ATOMIC_RELAXED, __HIP_MEMORY_SCOPE_AGENT) == 0u && ++sp < (1u << 22)) __builtin_amdgcn_s_sleep(8);
                        __builtin_amdgcn_fence(__ATOMIC_ACQUIRE, "agent"); asm volatile("s_waitcnt vmcnt(0)" ::: "memory"); }
                    __syncthreads();
                    pg8::Gemm g{(const bf16*)(ws + WS_YG), (const bf16*)(ws + WS_WG) + (size_t)l * 512 * 512, M, 512, 512, 64, 512, 30, 0, 30, 0, (size_t)32768, (size_t)262144};
                    const GluOrder S{48 + gj, 16, 1, gx};
                    EpiGlu E{(const bf16*)(ws + WS_YG), ka->in[I_BGLU] + l * 512, (bf16*)(ws + WS_HID), rsq + (size_t)(9 + l) * M, ZM};
                    pg8::gemm_phase<EpiGlu, GluOrder>(lds + RING_OFF, g, S, E);
                }
            }
            else {
                for (int i = 0; i < 4; ++i) {
                    const int idx = (gj - 16) * 4 + i; const OneUnit S{(idx >> 1) * 16 + 2 * gx + (idx & 1)};
                    {
                        SITE();
                        pg8::Gemm g{(const bf16*)(ws + WS_AEXT), (const bf16*)(ws + WS_WX) + (size_t)l * 32 * 256 * 256, 32 * 4096, 256, 256, AEXT_LD, 256, 4, (size_t)256 * 256 * 2, 30, 0, 0, 0};
                        EpiXS E{(const float2*)(ws + WS_AT) + (size_t)l * 32 * 64, (bf16*)(ws + WS_AEXT)};
                        pg8::gemm_phase<EpiXS, OneUnit>(lds + RING_OFF, g, S, E);
                    }
                }
                {
                    SITE();
                    pg8::Gemm g{(const bf16*)(ws + WS_AEXT), (const bf16*)(ws + WS_WY) + (size_t)l * 32 * 256 * 384, 32 * 4096, 256, 384, AEXT_LD, 384, 4, (size_t)256 * 384 * 2, 30, 0, 0, 0};
                    EpiY E{(bf16*)(ws + WS_YG)}; const FourUnits S4{(gj - 16) * 4, gx};
                    pg8::gemm_phase<EpiY, FourUnits>(lds + RING_OFF, g, S4, E);
                }
                xcd_barrier(sbar);
                if (gj == 16 && tid == 0) { SITE(); __hip_atomic_store((unsigned*)(ws + WS_CTL + CTL_YFLAG) + gx * DEPTH + l, 1u, __ATOMIC_RELAXED, __HIP_MEMORY_SCOPE_AGENT); }
                {
                    SITE();
                    pg8::Gemm g{(const bf16*)(ws + WS_YG), (const bf16*)(ws + WS_WG) + (size_t)l * 512 * 512, M, 512, 512, 64, 512, 30, 0, 30, 0, (size_t)32768, (size_t)262144};
                    const GluOrder S{gj - 16, 16, 3, gx};
                    EpiGlu E{(const bf16*)(ws + WS_YG), ka->in[I_BGLU] + l * 512, (bf16*)(ws + WS_HID), rsq + (size_t)(9 + l) * M, ZM};
                    pg8::gemm_phase<EpiGlu, GluOrder>(lds + RING_OFF, g, S, E);
                }
            }
        }
        SEAMG(pb + 1);
        if (HAS(4) && IN(pb + 3)) REP(4) {
            SITE();
            pg8::Gemm g{(const bf16*)(ws + WS_HID + PANEL_AMIX), (const bf16*)(ws + WS_WO) + (size_t)l * D * D, M, D, D, 64, D, 30, 0, 30, 0, (size_t)32768, PANEL};
            pg8::StaticOrder S; S.init(M, D, G, (int)blockIdx.x);
            EpiRes<true> E{(bf16*)(ws + WS_XB), rsq + (size_t)(9 + l) * M, rsq + (size_t)(2 * l + 1) * M, ZM};
            pg8::gemm_phase<EpiRes<true>, pg8::StaticOrder>(lds + RING_OFF, g, S, E);
        }
        SEAMC(pb + 3);
        if (HAS(5) && IN(pb + 4)) REP(5) {
            SITE();
            pg8::Gemm g{(const bf16*)(ws + WS_XB), (const bf16*)(ws + WS_WF1) + (size_t)l * NFF2 * D, M, NFF2, D, 64, D, 30, 0, 30, 0, (size_t)32768, (size_t)524288};
            pg8::StaticOrder S; S.init(M, NFF2, G, (int)blockIdx.x);
            EpiFfn E{rsq + (size_t)(2 * l + 1) * M, (bf16*)(ws + WS_HID), {}, -1};
            pg8::gemm_phase<EpiFfn, pg8::StaticOrder>(lds + RING_OFF, g, S, E);
        }
        SEAMC(pb + 4);
        if (HAS(6) && IN(pb + 5)) REP(6) {
            SITE();
            pg8::Gemm g{(const bf16*)(ws + WS_HID), (const bf16*)(ws + WS_WF2) + (size_t)l * D * DFF, M, D, DFF, 64, DFF, 30, 0, 30, 0, (size_t)256 * 128, (size_t)256 * DFF * 2};
            pg8::StaticOrder S; S.init(M, D, G, (int)blockIdx.x);
            EpiRes<false> E{(bf16*)(ws + WS_XB), nullptr, rsq + (size_t)(2 * l + 2) * M, ZM};
            if (l < DEPTH - 1) pg8::gemm_phase<EpiRes<false>, pg8::StaticOrder>(lds + RING_OFF, g, S, E);
            else {
                unsigned* tl = (unsigned*)(ws + WS_CTL + CTL_TAIL); volatile LAS unsigned* slot = MISC + 24;
                const int cls = gx * 8 + (gj & 7), pnq = gj >> 3, pm0 = 32 * gx + (gj & 7);
                if (pnq == 0 && tid == 0) __hip_atomic_store(tl + TL_READY + cls, 1u, __ATOMIC_RELAXED, __HIP_MEMORY_SCOPE_AGENT);
                {   const TwoUnits S2{pm0, pm0 + 8, pnq};
                    pg8::gemm_phase<EpiRes<false>, TwoUnits>(lds + RING_OFF, g, S2, E);
                    const unsigned m = tl_finish(tl, slot, pm0, pm0 + 8, 2);
                    if (m & 1u) final_norm_panel(kargs(), pm0, lane, wave);
                    if (m & 2u) final_norm_panel(kargs(), pm0 + 8, lane, wave); }
                for (;;) {
                    __syncthreads();
                    if (wave == 0) { const int c = tl_claim(tl, cls, lane); if (lane == 0) { if (c >= 0) __builtin_amdgcn_fence(__ATOMIC_ACQUIRE, "agent"); slot[1] = (unsigned)c; } }
                    __syncthreads();
                    const int c = (int)slot[1];
                    if (c < 0) break;
                    const int vc = c >> 3, vu = c & 7; const int pm = 32 * (vc >> 3) + (vc & 7) + 8 * (2 + (vu >> 2));
                    const OneUnitPN S1{pm, vu & 3};
                    pg8::gemm_phase<EpiRes<false>, OneUnitPN>(lds + RING_OFF, g, S1, E);
                    const unsigned m = tl_finish(tl, slot, pm, pm, 1);
                    if (m & 1u) final_norm_panel(kargs(), pm, lane, wave);
                }
            }
        }
        if (l < DEPTH - 1) SEAMC(pb + 5);
    }
#undef IN
#undef SEAM
}

extern "C" void kernel_launch(void* const* d_in, const int* in_sizes, int n_in, void* d_out, int out_size, void* d_ws, size_t ws_size, hipStream_t stream) {
    static int grid = 0;
    if (grid == 0) {
        if (n_in != 22 || in_sizes[0] != M * D || out_size != M * D || ws_size < WS_END) { fprintf(stderr, "kernel_launch: unexpected shapes (n_in %d, in0 %d, out %d, ws %zu < %zu); nothing launched\n", n_in, n_in > 0 ? in_sizes[0] : -1, out_size, ws_size, (size_t)WS_END); grid = -1; return; }
        int dev = 0, cus = 0, per_cu = 0;
        if (hipGetDevice(&dev) != hipSuccess || hipDeviceGetAttribute(&cus, hipDeviceAttributeMultiprocessorCount, dev) != hipSuccess) { grid = -1; return; }
        if (hipFuncSetAttribute((const void*)hymba_fwd, hipFuncAttributeMaxDynamicSharedMemorySize, LDS_BYTES) != hipSuccess) { fprintf(stderr, "kernel_launch: hipFuncSetAttribute failed\n"); grid = -1; return; }
        if (hipOccupancyMaxActiveBlocksPerMultiprocessor(&per_cu, (const void*)hymba_fwd, NWAVES * 64, LDS_BYTES) != hipSuccess || per_cu < 1)
            fprintf(stderr, "kernel_launch: note: occupancy query reports %d workgroups per CU\n", per_cu);
        (void)hipGetLastError();
        grid = cus;
        if (grid != 256) { fprintf(stderr, "kernel_launch: this kernel's label-group schedule is built for 256 CUs (got %d); nothing launched\n", grid); grid = -1; return; }
    }
    if (grid < 0) return;
    if (hipMemsetAsync((char*)d_ws + WS_CTL, 0, CTL_ZERO_BYTES, stream) != hipSuccess) return;
    Args a{};
    for (int i = 0; i < 22; ++i) a.in[i] = (const float*)d_in[i];
    a.out = (float*)d_out; a.ws = (unsigned char*)d_ws;
    a.ph_lo = 0; a.ph_hi = N_PHASES;
    hipLaunchKernelGGL(hymba_fwd, dim3(grid), dim3(NWAVES * 64), LDS_BYTES, stream, a);
}
```
